# Optimizing an MI355X kernel written in HIP

```python
import math
import jax, jax.numpy as jnp
from jax import lax
import numpy as np

D_MODEL = 2048
BATCH = 8
SEQ = 2048
DEPTH = 2

CTX_LEN = 256
GRID_W = 64
N_MIXERS = 2
N_LAYERS_A = (DEPTH + 1) // 2
N_LAYERS_B = DEPTH // 2
FFN_HIDDEN = -(-8 * D_MODEL // (3 * 256)) * 256
NORM_EPS = 1e-6
ROPE_BASE = 10000.0
Q_BLOCK = 128

DA_HEAD_DIM = 128
DA_HEADS = D_MODEL // (2 * DA_HEAD_DIM)
DA_V_DIM = 2 * DA_HEAD_DIM
DA_QK_WIDTH = DA_HEADS * 2 * DA_HEAD_DIM
DA_V_WIDTH = DA_HEADS * DA_V_DIM
DA_SCALE = DA_HEAD_DIM ** -0.5

MLA_HEADS = D_MODEL // 128
MLA_NOPE = 128
MLA_ROPE = 64
MLA_V = 128
MLA_Q_LORA = 512
MLA_KV_LORA = 512
MLA_IN_WIDTH = MLA_Q_LORA + MLA_KV_LORA + MLA_ROPE
MLA_SCALE = (MLA_NOPE + MLA_ROPE) ** -0.5

kernel_name = 'hybrid_diffattn_mla_dit_prefix'


def rms_norm(x, g):
    xf = x.astype(jnp.float32)
    y = xf * lax.rsqrt(jnp.mean(xf * xf, axis=-1, keepdims=True) + NORM_EPS)
    return (y * g.astype(jnp.float32)).astype(x.dtype)


def modulate(h, shift, scale):
    return h * (1 + scale) + shift


def swiglu(h, w_in, w_out):
    g, u = jnp.split(h @ w_in, 2, axis=-1)
    return (jax.nn.silu(g) * u) @ w_out


def axial_rope(rows, rot_dim):
    row = jnp.repeat(jnp.arange(rows, dtype=jnp.float32), GRID_W)
    col = jnp.tile(jnp.arange(GRID_W, dtype=jnp.float32), rows)
    n_freq = rot_dim // 4
    inv_freq = ROPE_BASE ** (-jnp.arange(n_freq, dtype=jnp.float32) / n_freq)
    ang = jnp.concatenate([row[:, None] * inv_freq, col[:, None] * inv_freq], axis=-1)
    return jnp.cos(ang), jnp.sin(ang)


def apply_rope(x, cos, sin):
    x1, x2 = jnp.split(x, 2, axis=-1)
    return jnp.concatenate([x1 * cos - x2 * sin, x1 * sin + x2 * cos], axis=-1).astype(x.dtype)


def sweep_query_blocks(fn, *q_arrays):
    B, S = q_arrays[0].shape[:2]
    nb = S // Q_BLOCK
    blocks = tuple(jnp.moveaxis(a.reshape(B, nb, Q_BLOCK, *a.shape[2:]), 1, 0) for a in q_arrays)
    out = lax.map(lambda qs: fn(*qs), blocks)
    out = jnp.moveaxis(out, 0, 1)
    return out.reshape(B, S, *out.shape[3:])


def diff_attend(q, k, v, lam):
    s = jnp.einsum('bqhmd,bkhmd->bhmqk', q, k).astype(jnp.float32) * DA_SCALE
    p = jax.nn.softmax(s, axis=-1)
    a = p[:, :, 0] - lam * p[:, :, 1]
    return jnp.einsum('bhqk,bkhe->bqhe', a.astype(v.dtype), v)


def diff_attention(h_lat, h_ctx, w_qkv, lam_vecs, subln_g, w_o, lam_init, cos, sin, ctx_out):
    def project(h):
        B, T, _ = h.shape
        q, k, v = jnp.split(h @ w_qkv, [DA_QK_WIDTH, 2 * DA_QK_WIDTH], axis=-1)
        return (q.reshape(B, T, DA_HEADS, 2, DA_HEAD_DIM),
                k.reshape(B, T, DA_HEADS, 2, DA_HEAD_DIM),
                v.reshape(B, T, DA_HEADS, DA_V_DIM))

    def finish(o):
        B, T = o.shape[:2]
        o = rms_norm(o, subln_g) * (1.0 - lam_init)
        return o.reshape(B, T, DA_V_WIDTH) @ w_o

    lv = lam_vecs.astype(jnp.float32)
    lam = jnp.exp(jnp.sum(lv[0] * lv[1])) - jnp.exp(jnp.sum(lv[2] * lv[3])) + lam_init

    q_c, k_c, v_c = project(h_ctx)
    q_l, k_l, v_l = project(h_lat)
    cs, sn = cos[None, :, None, None, :], sin[None, :, None, None, :]
    q_l = apply_rope(q_l, cs, sn)
    k_l = apply_rope(k_l, cs, sn)
    k_all = jnp.concatenate([k_c, k_l], axis=1)
    v_all = jnp.concatenate([v_c, v_l], axis=1)

    out_lat = finish(sweep_query_blocks(lambda qb: diff_attend(qb, k_all, v_all, lam), q_l))
    out_ctx = finish(diff_attend(q_c, k_c, v_c, lam)) if ctx_out else None
    return out_lat, out_ctx


def mla_project(h, w_in, q_norm_g, w_q_up, kv_norm_g, w_kv_up, cos=None, sin=None):
    B, T, _ = h.shape
    c_q, c_kv, k_rope = jnp.split(h @ w_in, [MLA_Q_LORA, MLA_Q_LORA + MLA_KV_LORA], axis=-1)
    q = (rms_norm(c_q, q_norm_g) @ w_q_up).reshape(B, T, MLA_HEADS, MLA_NOPE + MLA_ROPE)
    q_nope, q_rope = jnp.split(q, [MLA_NOPE], axis=-1)
    kv = (rms_norm(c_kv, kv_norm_g) @ w_kv_up).reshape(B, T, MLA_HEADS, MLA_NOPE + MLA_V)
    k_nope, v = jnp.split(kv, [MLA_NOPE], axis=-1)
    if cos is not None:
        q_rope = apply_rope(q_rope, cos[None, :, None, :], sin[None, :, None, :])
        k_rope = apply_rope(k_rope, cos[None], sin[None])
    return q_nope, q_rope, k_nope, k_rope, v


def mla_attend(q_nope, q_rope, k_nope, k_rope, v):
    s = (jnp.einsum('bqhd,bkhd->bhqk', q_nope, k_nope)
         + jnp.einsum('bqhr,bkr->bhqk', q_rope, k_rope)).astype(jnp.float32) * MLA_SCALE
    p = jax.nn.softmax(s, axis=-1)
    return jnp.einsum('bhqk,bkhd->bqhd', p.astype(v.dtype), v)


def mla_attention(h_lat, h_ctx, w_in, q_norm_g, w_q_up, kv_norm_g, w_kv_up, w_o, cos, sin, ctx_out):
    qn_c, qr_c, kn_c, kr_c, v_c = mla_project(h_ctx, w_in, q_norm_g, w_q_up, kv_norm_g, w_kv_up)
    qn_l, qr_l, kn_l, kr_l, v_l = mla_project(h_lat, w_in, q_norm_g, w_q_up, kv_norm_g, w_kv_up, cos, sin)
    kn_all = jnp.concatenate([kn_c, kn_l], axis=1)
    kr_all = jnp.concatenate([kr_c, kr_l], axis=1)
    v_all = jnp.concatenate([v_c, v_l], axis=1)

    def finish(o):
        B, T = o.shape[:2]
        return o.reshape(B, T, MLA_HEADS * MLA_V) @ w_o

    out_lat = finish(sweep_query_blocks(
        lambda qn, qr: mla_attend(qn, qr, kn_all, kr_all, v_all), qn_l, qr_l))
    out_ctx = finish(mla_attend(qn_c, qr_c, kn_c, kr_c, v_c)) if ctx_out else None
    return out_lat, out_ctx


def _normal(key, shape, scale):
    return jax.random.normal(key, shape, jnp.float32) * scale


def setup_inputs(seed: int = 0) -> dict:
    key = jax.random.key(seed)
    ks = jax.random.split(key, 24)
    D = D_MODEL
    return {
        'x': _normal(ks[0], (BATCH, SEQ, D), 1.0),
        'c': _normal(ks[1], (BATCH, D), 1.0),
        'ctx': _normal(ks[2], (BATCH, CTX_LEN, D), 1.0),
        'c_ctx': _normal(ks[3], (D,), 1.0),
        'ada_w': _normal(ks[4], (DEPTH, D, 6 * D), 0.5 * D ** -0.5),
        'ada_b': _normal(ks[5], (DEPTH, 6 * D), 0.02),
        'norm_mix_g': 1.0 + _normal(ks[6], (DEPTH, D), 0.02),
        'norm_ffn_g': 1.0 + _normal(ks[7], (DEPTH, D), 0.02),
        'ffn_w_in': _normal(ks[8], (DEPTH, D, 2 * FFN_HIDDEN), D ** -0.5),
        'ffn_w_out': _normal(ks[9], (DEPTH, FFN_HIDDEN, D), FFN_HIDDEN ** -0.5),
        'da_w_qkv': _normal(ks[10], (N_LAYERS_A, D, 2 * DA_QK_WIDTH + DA_V_WIDTH), D ** -0.5),
        'da_lambda': _normal(ks[11], (N_LAYERS_A, 4, DA_HEAD_DIM), 0.1),
        'da_subln_g': 1.0 + _normal(ks[12], (N_LAYERS_A, DA_V_DIM), 0.02),
        'da_w_o': _normal(ks[13], (N_LAYERS_A, DA_V_WIDTH, D), DA_V_WIDTH ** -0.5),
        'mla_w_in': _normal(ks[14], (N_LAYERS_B, D, MLA_IN_WIDTH), D ** -0.5),
        'mla_q_norm_g': 1.0 + _normal(ks[15], (N_LAYERS_B, MLA_Q_LORA), 0.02),
        'mla_w_q_up': _normal(ks[16], (N_LAYERS_B, MLA_Q_LORA, MLA_HEADS * (MLA_NOPE + MLA_ROPE)), MLA_Q_LORA ** -0.5),
        'mla_kv_norm_g': 1.0 + _normal(ks[17], (N_LAYERS_B, MLA_KV_LORA), 0.02),
        'mla_w_kv_up': _normal(ks[18], (N_LAYERS_B, MLA_KV_LORA, MLA_HEADS * (MLA_NOPE + MLA_V)), MLA_KV_LORA ** -0.5),
        'mla_w_o': _normal(ks[19], (N_LAYERS_B, MLA_HEADS * MLA_V, D), (MLA_HEADS * MLA_V) ** -0.5),
        'final_norm_g': 1.0 + _normal(ks[20], (D,), 0.02),
    }


def reference(x, c, ctx, c_ctx, ada_w, ada_b, norm_mix_g, norm_ffn_g, ffn_w_in, ffn_w_out,
              da_w_qkv, da_lambda, da_subln_g, da_w_o,
              mla_w_in, mla_q_norm_g, mla_w_q_up, mla_kv_norm_g, mla_w_kv_up, mla_w_o,
              final_norm_g):
    ROWS = x.shape[1] // GRID_W
    da_cos, da_sin = axial_rope(ROWS, DA_HEAD_DIM)
    mla_cos, mla_sin = axial_rope(ROWS, MLA_ROPE)
    silu_c = jax.nn.silu(c)
    silu_cc = jax.nn.silu(c_ctx)
    xc = ctx
    for i in range(DEPTH):
        ctx_out = i < DEPTH - 1
        j = i // N_MIXERS
        mod = jnp.split(silu_c @ ada_w[i] + ada_b[i], 6, axis=-1)
        mod = [m[:, None, :] for m in mod]
        mod_c = jnp.split(silu_cc @ ada_w[i] + ada_b[i], 6, axis=-1)
        h_lat = modulate(rms_norm(x, norm_mix_g[i]), mod[0], mod[1])
        h_ctx = modulate(rms_norm(xc, norm_mix_g[i]), mod_c[0], mod_c[1])
        if i % N_MIXERS == 0:
            lam_init = 0.8 - 0.6 * math.exp(-0.3 * i)
            a_lat, a_ctx = diff_attention(h_lat, h_ctx, da_w_qkv[j], da_lambda[j], da_subln_g[j],
                                          da_w_o[j], lam_init, da_cos, da_sin, ctx_out)
        else:
            a_lat, a_ctx = mla_attention(h_lat, h_ctx, mla_w_in[j], mla_q_norm_g[j], mla_w_q_up[j],
                                         mla_kv_norm_g[j], mla_w_kv_up[j], mla_w_o[j],
                                         mla_cos, mla_sin, ctx_out)
        x = x + mod[2] * a_lat
        x = x + mod[5] * swiglu(modulate(rms_norm(x, norm_ffn_g[i]), mod[3], mod[4]), ffn_w_in[i], ffn_w_out[i])
        if ctx_out:
            xc = xc + mod_c[2] * a_ctx
            xc = xc + mod_c[5] * swiglu(modulate(rms_norm(xc, norm_ffn_g[i]), mod_c[3], mod_c[4]),
                                        ffn_w_in[i], ffn_w_out[i])
    return rms_norm(x, final_norm_g)
```

```cpp
#define ONE_LAUNCH 0
#define ATT1_SDEPTH 1
#define ATT0_SDEPTH 2
#include <hip/hip_runtime.h>
#include <hip/hip_cooperative_groups.h>
#include <cstdio>
#include <cstdint>
namespace cg = cooperative_groups;
__device__ __forceinline__ int fresh_tid() { int t = threadIdx.x; asm volatile("" : "+v"(t)); return t & 511; }

#ifndef ONE_LAUNCH
#define ONE_LAUNCH 1
#endif

namespace pg8 {
#define PG8_LAS __attribute__((address_space(3)))
typedef unsigned short bf16_t;
typedef short bf16x8 __attribute__((ext_vector_type(8)));
typedef float f32x4 __attribute__((ext_vector_type(4)));
typedef unsigned u32x4 __attribute__((ext_vector_type(4)));
constexpr int BM = 256, BK = 64, HALF = 128, HTB = HALF * BK * 2  , STAGE_BYTES = 8 * HTB, NXCD = 8, WGM = 8;

__host__ __device__ __forceinline__ int lds_byte(int r, int c) { const int st = (r >> 4) * 2 + (c >> 5), rr = r & 15, cc = c & 31, ob = rr * 64 + cc * 2; return st * 1024 + (ob ^ (((ob >> 9) & 1) << 5)); }
__host__ __device__ __forceinline__ void stage_rc(int b, int& R, int& C) { const int st = b / 1024, sb = b % 1024, swz = sb ^ (((sb >> 9) & 1) << 5); R = (st >> 1) * 16 + swz / 64; C = (st & 1) * 32 + (swz % 64) / 2; }
__host__ __device__ __forceinline__ int perm32(int rho) { const int n = rho >> 4, i = rho & 15; return 8 * (i >> 2) + 4 * n + (i & 3); }

struct Unit { int pm, pn; };
struct Gemm { const bf16_t* A; const bf16_t* Bt; int M, N, K; };

struct StaticOrder {
    int nM, nN, nwg, G, c, lat;
    __host__ __device__ void init(int M, int N, int G_, int c_, int lat_only) { lat = lat_only; nM = lat_only ? (M / BM) / 9 * 8 : M / BM; nN = N / BM; nwg = nM * nN; G = G_; c = c_; }
    __host__ __device__ bool next(int i, Unit& u) const {
        const long L = (long)i * G + c; if (L >= nwg) return false;
        int wgid = (int)L; { const int q = nwg / NXCD, r = nwg % NXCD, xcd = wgid % NXCD, off = wgid / NXCD; wgid = (xcd < r ? xcd * (q + 1) : r * (q + 1) + (xcd - r) * q) + off; }
        const int nig = WGM * nN, gid = wgid / nig, fm = gid * WGM, gsz = (nM - fm) < WGM ? (nM - fm) : WGM;
        int pm = fm + ((wgid % nig) % gsz); u.pn = (wgid % nig) / gsz;
        if (lat) pm = (pm >> 3) * 9 + 1 + (pm & 7);
        u.pm = pm; return true;
    }
    __device__ __forceinline__ void a_ready(const Unit&) const {}
    __device__ __forceinline__ void done(const Unit&) const {}
};

__device__ __forceinline__ unsigned cvt_pk_bf16(float lo, float hi) { unsigned r; asm volatile("v_cvt_pk_bf16_f32 %0, %1, %2" : "=v"(r) : "v"(lo), "v"(hi)); return r; }

struct EpiBf16 {
    static constexpr bool PERM = true, AFTER_DRAIN = false;
    bf16_t* O; int ldc;
    __device__ __forceinline__ void operator()(const f32x4 (&acc)[2][2][4][2], const Unit& u, int wr, int wc, int fr, int fq) const {
        const int row0 = u.pm * BM + wr * 64 + fr; const int col0 = u.pn * BM + wc * 32 + 8 * fq;
#pragma unroll
        for (int ai = 0; ai < 2; ++ai)
#pragma unroll
            for (int m = 0; m < 4; ++m) { bf16_t* rowp = O + (size_t)(row0 + ai * HALF + m * 16) * ldc + col0;
#pragma unroll
                for (int bj = 0; bj < 2; ++bj) { const f32x4 v0 = acc[ai][bj][m][0], v1 = acc[ai][bj][m][1];
                    u32x4 w; w.x = cvt_pk_bf16(v0[0], v0[1]); w.y = cvt_pk_bf16(v0[2], v0[3]); w.z = cvt_pk_bf16(v1[0], v1[1]); w.w = cvt_pk_bf16(v1[2], v1[3]);
                    *(u32x4*)(rowp + bj * HALF) = w; } }
    }
};
struct EpiSwiGLU {
    static constexpr bool PERM = true, AFTER_DRAIN = false;
    bf16_t* O; int ldc;
    __device__ __forceinline__ float sg(float g, float u) const { return g * u * __builtin_amdgcn_rcpf(1.f + __builtin_amdgcn_exp2f(-1.4426950408889634f * g)); }
    __device__ __forceinline__ void operator()(const f32x4 (&acc)[2][2][4][2], const Unit& u, int wr, int wc, int fr, int fq) const {
        const int row0 = u.pm * BM + wr * 64 + fr; const int col0 = u.pn * HALF + wc * 32 + 8 * fq;
#pragma unroll
        for (int ai = 0; ai < 2; ++ai)
#pragma unroll
            for (int m = 0; m < 4; ++m) { bf16_t* rowp = O + (size_t)(row0 + ai * HALF + m * 16) * ldc + col0;
                const f32x4 g0 = acc[ai][0][m][0], g1 = acc[ai][0][m][1], u0 = acc[ai][1][m][0], u1 = acc[ai][1][m][1];
                u32x4 w; w.x = cvt_pk_bf16(sg(g0[0], u0[0]), sg(g0[1], u0[1])); w.y = cvt_pk_bf16(sg(g0[2], u0[2]), sg(g0[3], u0[3]));
                w.z = cvt_pk_bf16(sg(g1[0], u1[0]), sg(g1[1], u1[1])); w.w = cvt_pk_bf16(sg(g1[2], u1[2]), sg(g1[3], u1[3]));
                *(u32x4*)rowp = w; }
    }
};
struct EpiRes {
    static constexpr bool PERM = false, AFTER_DRAIN = false;
    float* X; const float* xin; const float* cin; const float* gate;
    __device__ __forceinline__ void operator()(const f32x4 (&acc)[2][2][4][2], const Unit& u, int wr, int wc, int fr, int fq) const {
        const int b = u.pm / 9, r9 = u.pm - 9 * b; const int brow = r9 == 0 ? 8 : b;
        const float* g = gate + (size_t)brow * 12288; const int col0 = u.pn * BM + wc * 32 + 4 * fq; const int rl = wr * 64 + fr;
        const float* res = xin ? (r9 == 0 ? cin + (size_t)b * 256 * 2048 : xin + ((size_t)b * 2048 + (size_t)(r9 - 1) * 256) * 2048) : X + (size_t)u.pm * BM * 2048;
        float* out = X + (size_t)u.pm * BM * 2048;
        f32x4 gv[2][2];
#pragma unroll
        for (int bj = 0; bj < 2; ++bj)
#pragma unroll
            for (int n = 0; n < 2; ++n) gv[bj][n] = *(const f32x4*)(g + col0 + bj * HALF + n * 16);
#pragma unroll
        for (int ai = 0; ai < 2; ++ai)
#pragma unroll
            for (int m = 0; m < 4; ++m) { const size_t off = (size_t)(rl + ai * HALF + m * 16) * 2048 + col0;
#pragma unroll
                for (int bj = 0; bj < 2; ++bj)
#pragma unroll
                    for (int n = 0; n < 2; ++n) { const f32x4 bs = *(const f32x4*)(res + off + bj * HALF + n * 16);
                        *(f32x4*)(out + off + bj * HALF + n * 16) = bs + gv[bj][n] * acc[ai][bj][m][n]; } }
    }
};

template <class Epi, class Sched, bool ALIGN_EPI = false, bool SP2 = false>
__device__ __forceinline__ void gemm_phase(PG8_LAS unsigned char* lds, const Gemm g, const Sched& S, const Epi& E) {
    const int tid = fresh_tid(), wid = __builtin_amdgcn_readfirstlane(tid >> 6), lane = tid & 63, wr = wid >> 2, wc = wid & 3, fr = lane & 15, fq = lane >> 4;
    const int K = g.K, nt = K / BK;
    unsigned voffA[2], voffB[2];
#pragma unroll
    for (int i = 0; i < 2; ++i) { int R, C; stage_rc(tid * 16 + i * 8192, R, C); const int Rb = Epi::PERM ? ((R & ~31) + perm32(R & 31)) : R;
        voffA[i] = (unsigned)(R * K + C) * 2u; voffB[i] = (unsigned)(Rb * K + C) * 2u; }
    const size_t kstep = (size_t)(BK * 2);
    const size_t hstep = (size_t)HALF * K * 2;
    const size_t tstep = 2 * hstep;
    const unsigned ldsw = (unsigned)wid * 1024u;
    const int aoff = lds_byte(wr * 64 + fr, fq * 8), boff = lds_byte(wc * 32 + fr, fq * 8);
#define PG8_SA(b, h) (((b) * 2 + (h)) * HTB)
#define PG8_SB(b, h) ((4 + (b) * 2 + (h)) * HTB)
#define PG8_STAGE(bufoff, gbase, voff) do { _Pragma("unroll") for (int _i = 0; _i < 2; ++_i) \
        __builtin_amdgcn_global_load_lds((const unsigned*)((const char*)(gbase) + (voff)[_i]), (PG8_LAS unsigned*)(lds + (bufoff) + ldsw + _i * 8192), 16, 0, 0); } while (0)
#define PG8_LDA(dst, b, h) do { _Pragma("unroll") for (int m = 0; m < 4; ++m) _Pragma("unroll") for (int k = 0; k < 2; ++k) dst[m][k] = *(const PG8_LAS bf16x8*)(lds + PG8_SA(b, h) + aoff + m * 2048 + k * 1024); } while (0)
#define PG8_LDB(dst, b, h) do { _Pragma("unroll") for (int n = 0; n < 2; ++n) _Pragma("unroll") for (int k = 0; k < 2; ++k) dst[n][k] = *(const PG8_LAS bf16x8*)(lds + PG8_SB(b, h) + boff + n * 2048 + k * 1024); } while (0)
#define PG8_MMA(ai, bj, At, Bt) do { __builtin_amdgcn_s_setprio(1); _Pragma("unroll") for (int m = 0; m < 4; ++m) _Pragma("unroll") for (int n = 0; n < 2; ++n) _Pragma("unroll") for (int k = 0; k < 2; ++k) \
        acc[ai][bj][m][n] = __builtin_amdgcn_mfma_f32_16x16x32_bf16(Bt[n][k], At[m][k], acc[ai][bj][m][n], 0, 0, 0); __builtin_amdgcn_s_setprio(0); } while (0)
#define PG8_WAIT_V(n) asm volatile("s_waitcnt vmcnt(" #n ")" ::: "memory")
#define PG8_WAIT_L(n) asm volatile("s_waitcnt lgkmcnt(" #n ")" ::: "memory")
#define PG8_BAR __builtin_amdgcn_s_barrier()
#define PG8_SCHED __builtin_amdgcn_sched_barrier(0)
    Unit cur, nxt; int ui = 0;
    if (!S.next(0, cur)) return;
    f32x4 acc[2][2][4][2];
#pragma unroll
    for (int a = 0; a < 2; ++a)
#pragma unroll
        for (int b = 0; b < 2; ++b)
#pragma unroll
            for (int m = 0; m < 4; ++m)
#pragma unroll
                for (int n = 0; n < 2; ++n) acc[a][b][m][n] = (f32x4){0.f, 0.f, 0.f, 0.f};
    bf16x8 At[4][2], B0[2][2], B1[2][2];
    const char* cA = (const char*)g.A + (size_t)cur.pm * tstep; const char* cB = (const char*)g.Bt + (size_t)cur.pn * tstep;
    S.a_ready(cur);
    if constexpr (SP2) {
        PG8_STAGE(PG8_SB(0, 0), cB, voffB); PG8_STAGE(PG8_SB(0, 1), cB + hstep, voffB); PG8_STAGE(PG8_SA(0, 0), cA, voffA); PG8_STAGE(PG8_SA(0, 1), cA + hstep, voffA);
        if (wr == 1) PG8_BAR;
        PG8_WAIT_V(2); PG8_BAR;
        PG8_STAGE(PG8_SB(1, 0), cB + kstep, voffB); PG8_STAGE(PG8_SA(1, 0), cA + kstep, voffA); PG8_STAGE(PG8_SB(1, 1), cB + hstep + kstep, voffB);
        PG8_WAIT_V(6); PG8_BAR;
    } else {
        PG8_STAGE(PG8_SB(0, 0), cB, voffB); PG8_STAGE(PG8_SA(0, 0), cA, voffA); PG8_STAGE(PG8_SB(0, 1), cB + hstep, voffB); PG8_STAGE(PG8_SA(0, 1), cA + hstep, voffA);
        if (wr == 1) PG8_BAR;
        PG8_WAIT_V(4); PG8_BAR;
        PG8_STAGE(PG8_SB(1, 0), cB + kstep, voffB); PG8_STAGE(PG8_SA(1, 0), cA + kstep, voffA); PG8_STAGE(PG8_SB(1, 1), cB + hstep + kstep, voffB);
        PG8_WAIT_V(6); PG8_BAR;
    }
    for (;;) {
        const bool has_next = S.next(ui + 1, nxt);
        const char* nA = has_next ? (const char*)g.A + (size_t)nxt.pm * tstep : cA; const char* nB = has_next ? (const char*)g.Bt + (size_t)nxt.pn * tstep : cB;
        for (int t = 0; t < nt; t += 2) {
            const bool last = (t == nt - 2);
            const char* a1 = cA + (size_t)(t + 1) * kstep;
            const char* a2 = last ? nA : cA + (size_t)(t + 2) * kstep; const char* b2 = last ? nB : cB + (size_t)(t + 2) * kstep;
            const char* a3 = a2 + kstep; const char* b3 = b2 + kstep;
            if (last && has_next) S.a_ready(nxt);
            if constexpr (SP2) {
            PG8_LDB(B0, 0, 0); PG8_LDB(B1, 0, 1); PG8_SCHED; PG8_LDA(At, 0, 0); PG8_STAGE(PG8_SA(1, 1), a1 + hstep, voffA);
            PG8_WAIT_V(8); PG8_WAIT_L(0); PG8_BAR; PG8_MMA(0, 0, At, B0); PG8_MMA(0, 1, At, B1); PG8_BAR; PG8_SCHED;
            PG8_LDA(At, 0, 1); PG8_STAGE(PG8_SB(0, 0), b2, voffB); PG8_STAGE(PG8_SB(0, 1), b2 + hstep, voffB); PG8_STAGE(PG8_SA(0, 0), a2, voffA);
            PG8_WAIT_V(8); PG8_WAIT_L(0); PG8_BAR; PG8_MMA(1, 0, At, B0); PG8_MMA(1, 1, At, B1); PG8_BAR; PG8_SCHED;
            PG8_LDB(B0, 1, 0); PG8_LDB(B1, 1, 1); PG8_SCHED; PG8_LDA(At, 1, 0); PG8_STAGE(PG8_SA(0, 1), a2 + hstep, voffA);
            PG8_WAIT_V(8); PG8_WAIT_L(0); PG8_BAR; PG8_MMA(0, 0, At, B0); PG8_MMA(0, 1, At, B1); PG8_BAR; PG8_SCHED;
            PG8_LDA(At, 1, 1); PG8_STAGE(PG8_SB(1, 0), b3, voffB); PG8_STAGE(PG8_SB(1, 1), b3 + hstep, voffB); PG8_STAGE(PG8_SA(1, 0), a3, voffA);
            PG8_WAIT_V(8); PG8_WAIT_L(0); PG8_BAR; PG8_MMA(1, 0, At, B0); PG8_MMA(1, 1, At, B1); PG8_BAR; PG8_SCHED;
            } else {
            PG8_LDB(B0, 0, 0); PG8_SCHED; PG8_LDA(At, 0, 0); PG8_STAGE(PG8_SA(1, 1), a1 + hstep, voffA);
            PG8_WAIT_L(8); PG8_BAR; PG8_WAIT_L(0); PG8_MMA(0, 0, At, B0); PG8_BAR; PG8_SCHED;
            PG8_LDB(B1, 0, 1); PG8_STAGE(PG8_SB(0, 0), b2, voffB);
            PG8_BAR; PG8_WAIT_L(0); PG8_MMA(0, 1, At, B1); PG8_BAR;
            PG8_LDA(At, 0, 1); PG8_STAGE(PG8_SA(0, 0), a2, voffA);
            PG8_BAR; PG8_WAIT_L(0); PG8_MMA(1, 0, At, B0); PG8_BAR; PG8_SCHED;
            PG8_STAGE(PG8_SB(0, 1), b2 + hstep, voffB);
            PG8_WAIT_V(6); PG8_BAR; PG8_MMA(1, 1, At, B1); PG8_BAR;
            PG8_LDB(B0, 1, 0); PG8_SCHED; PG8_LDA(At, 1, 0); PG8_STAGE(PG8_SA(0, 1), a2 + hstep, voffA);
            PG8_WAIT_L(8); PG8_BAR; PG8_WAIT_L(0); PG8_MMA(0, 0, At, B0); PG8_BAR; PG8_SCHED;
            PG8_LDB(B1, 1, 1); PG8_STAGE(PG8_SB(1, 0), b3, voffB);
            PG8_BAR; PG8_WAIT_L(0); PG8_MMA(0, 1, At, B1); PG8_BAR;
            PG8_LDA(At, 1, 1); PG8_STAGE(PG8_SA(1, 0), a3, voffA);
            PG8_BAR; PG8_WAIT_L(0); PG8_MMA(1, 0, At, B0); PG8_BAR; PG8_SCHED;
            PG8_STAGE(PG8_SB(1, 1), b3 + hstep, voffB);
            PG8_WAIT_V(6); PG8_BAR; PG8_MMA(1, 1, At, B1); PG8_BAR;
            }
        }
        if constexpr (ALIGN_EPI) { if (wr == 0) PG8_BAR; }
        if constexpr (!Epi::AFTER_DRAIN) { E(acc, cur, wr, wc, fr, fq); S.done(cur); }
        if (!has_next) break;
#pragma unroll
        for (int a = 0; a < 2; ++a)
#pragma unroll
            for (int b = 0; b < 2; ++b)
#pragma unroll
                for (int m = 0; m < 4; ++m)
#pragma unroll
                    for (int n = 0; n < 2; ++n) acc[a][b][m][n] = (f32x4){0.f, 0.f, 0.f, 0.f};
        cur = nxt; cA = nA; cB = nB; ++ui;
        if constexpr (ALIGN_EPI) { if (wr == 1) PG8_BAR; }
    }
    PG8_WAIT_V(0);
    if constexpr (!ALIGN_EPI) { if (wr == 0) PG8_BAR; }
    PG8_BAR;
    if constexpr (Epi::AFTER_DRAIN) { E.fused(acc, cur, wr, wc, fr, fq, lds, wid, lane); S.done(cur); }
#undef PG8_SA
#undef PG8_SB
#undef PG8_STAGE
#undef PG8_LDA
#undef PG8_LDB
#undef PG8_MMA
#undef PG8_WAIT_V
#undef PG8_WAIT_L
#undef PG8_BAR
#undef PG8_SCHED
}
}

namespace att {
typedef unsigned short bf16_t;
using bf16x8 = __attribute__((ext_vector_type(8))) short;
using s16x4  = __attribute__((ext_vector_type(4))) short;
using f32x16 = __attribute__((ext_vector_type(16))) float;
using f32x4  = __attribute__((ext_vector_type(4))) float;
using u32x4  = __attribute__((ext_vector_type(4))) unsigned;
constexpr int NW = 8, QBLK = 32, KVBLK = 64;
constexpr float THR = 8.f;
constexpr int SHM_V = KVBLK * 128 * 2, SHM_K = KVBLK * 128 * 2, SHM_KR = KVBLK * 64 * 2;
constexpr int OFF_V = 0, OFF_K = 2 * SHM_V, OFF_KR = OFF_K + 2 * SHM_K, OFF_WS = OFF_KR + 2 * SHM_KR, OFF_QR = OFF_WS + NW * 64 * 4, ATT_LDS = OFF_QR + NW * 4096;
#define KSWZ(row, colB) ((row) * 256 + ((colB) ^ (((row) & 7) << 4)))
#define KRSWZ(row, colB) ((row) * 128 + ((colB) ^ (((row) & 7) << 4)))
#define SBAR() __builtin_amdgcn_sched_barrier(0)
__device__ __forceinline__ int crow(int r, int hi) { return (r & 3) + 8 * (r >> 2) + 4 * hi; }
__device__ __forceinline__ unsigned cvtpk(float lo, float hi) { unsigned r; asm volatile("v_cvt_pk_bf16_f32 %0, %1, %2" : "=v"(r) : "v"(lo), "v"(hi)); return r; }
__device__ __forceinline__ float bf2f(short s) { return __uint_as_float(((unsigned)(unsigned short)s) << 16); }

template <int DQK> struct SC { static constexpr float SCALE = DQK == 192 ? 0.07216878364870322f : 0.08838834764831845f; };

template <int DQK>
__device__ __forceinline__ void partialSM(f32x16& p0, f32x16& p1, float& m_reg, float& mn, float& alpha) {
  constexpr float SCALE = SC<DQK>::SCALE; constexpr float C = SCALE * 1.4426950408889634f;
  float pmax = p0[0]; for (int r = 1; r < 16; ++r) pmax = fmaxf(pmax, p0[r]); for (int r = 0; r < 16; ++r) pmax = fmaxf(pmax, p1[r]);
  { auto rr = __builtin_amdgcn_permlane32_swap(__float_as_uint(pmax), __float_as_uint(pmax), false, false);
    pmax = fmaxf(__uint_as_float(rr[0]), __uint_as_float(rr[1])); }
  if (__builtin_expect(__all(pmax - m_reg <= THR / SCALE), 1)) { mn = m_reg; alpha = 1.f; }
  else { mn = fmaxf(m_reg, pmax); alpha = __builtin_amdgcn_exp2f((m_reg - mn) * C); m_reg = mn; }
  float mnC = -mn * C;
  for (int r = 0; r < 16; ++r) p0[r] = fmaf(p0[r], C, mnC); for (int r = 0; r < 16; ++r) p1[r] = fmaf(p1[r], C, mnC);
  for (int r = 0; r < 16; ++r) p0[r] = __builtin_amdgcn_exp2f(p0[r]);
}
__device__ __forceinline__ void finishSM(f32x16& p0, f32x16& p1, float alpha, float& l_reg, bf16x8& pa0, bf16x8& pa1, bf16x8& pa2, bf16x8& pa3) {
  for (int r = 0; r < 16; ++r) p1[r] = __builtin_amdgcn_exp2f(p1[r]);
  float ps = 0; for (int r = 0; r < 16; ++r) ps += p0[r]; for (int r = 0; r < 16; ++r) ps += p1[r];
  { auto rr = __builtin_amdgcn_permlane32_swap(__float_as_uint(ps), __float_as_uint(ps), false, false);
    ps = __uint_as_float(rr[0]) + __uint_as_float(rr[1]); }
  l_reg = l_reg * alpha + ps;
#define PK4(P, BASE, OUT) do { unsigned a0 = cvtpk(P[BASE + 0], P[BASE + 1]), a1 = cvtpk(P[BASE + 2], P[BASE + 3]);   \
    unsigned b0 = cvtpk(P[BASE + 4], P[BASE + 5]), b1 = cvtpk(P[BASE + 6], P[BASE + 7]);                              \
    auto r0 = __builtin_amdgcn_permlane32_swap(a0, b0, false, false); auto r1 = __builtin_amdgcn_permlane32_swap(a1, b1, false, false); \
    u32x4 w = {r0[0], r1[0], r0[1], r1[1]}; OUT = *reinterpret_cast<bf16x8*>(&w); } while (0)
  PK4(p0, 0, pa0); PK4(p0, 8, pa1); PK4(p1, 0, pa2); PK4(p1, 8, pa3);
#undef PK4
}
template <int DQK>
__device__ __forceinline__ void qkt(f32x16& p0, f32x16& p1, const char* Ks, const char* KRs, const bf16x8* qr, const char* qrl, int r32, int hi) {
  p0 = f32x16{}; p1 = f32x16{};
#pragma unroll
  for (int d0 = 0; d0 < 8; ++d0) { int cb = (d0 * 16 + hi * 8) * 2;
    bf16x8 b0 = *reinterpret_cast<const bf16x8*>(Ks + KSWZ(r32, cb));
    bf16x8 b1 = *reinterpret_cast<const bf16x8*>(Ks + KSWZ(32 + r32, cb));
    p0 = __builtin_amdgcn_mfma_f32_32x32x16_bf16(b0, qr[d0], p0, 0, 0, 0);
    p1 = __builtin_amdgcn_mfma_f32_32x32x16_bf16(b1, qr[d0], p1, 0, 0, 0); }
  if constexpr (DQK == 192) {
#pragma unroll
    for (int d0 = 0; d0 < 4; ++d0) { int cb = (d0 * 16 + hi * 8) * 2;
      bf16x8 b0 = *reinterpret_cast<const bf16x8*>(KRs + KRSWZ(r32, cb));
      bf16x8 b1 = *reinterpret_cast<const bf16x8*>(KRs + KRSWZ(32 + r32, cb));
      const bf16x8 qx = *reinterpret_cast<const bf16x8*>(qrl + d0 * 1024);
      p0 = __builtin_amdgcn_mfma_f32_32x32x16_bf16(b0, qx, p0, 0, 0, 0);
      p1 = __builtin_amdgcn_mfma_f32_32x32x16_bf16(b1, qx, p1, 0, 0, 0); }
  }
}
__device__ __forceinline__ int v_st(int k, int c) { const int kk = (k & ~0xC) | ((k & 4) << 1) | ((k & 8) >> 1); return ((kk >> 3) * 4 + (c >> 5)) * 512 + ((kk & 7) * 32 + (c & 31)) * 2; }
__device__ __forceinline__ int v_rd_base(int lane) { return ((lane & 3) << 3) | (((lane >> 2) & 3) << 6) | (((lane >> 4) & 1) << 5) | (((lane >> 5) & 1) << 8); }
constexpr int v_rd_off(int d0, int ks, int half) { return d0 * 512 + ks * 4096 + half * 2048; }
template <int OFF> __device__ __forceinline__ s16x4 tr_read(int vb) {
  s16x4 r; asm volatile("ds_read_b64_tr_b16 %0, %1 offset:%2" : "=&v"(r) : "v"(vb), "i"(OFF) : "memory"); return r;
}
template <int D0> __device__ __forceinline__ void pv_one(f32x16& od, int vb, bf16x8 pa0, bf16x8 pa1, bf16x8 pa2, bf16x8 pa3) {
  const s16x4 l0 = tr_read<v_rd_off(D0, 0, 0)>(vb), h0 = tr_read<v_rd_off(D0, 0, 1)>(vb), l1 = tr_read<v_rd_off(D0, 1, 0)>(vb), h1 = tr_read<v_rd_off(D0, 1, 1)>(vb);
  const s16x4 l2 = tr_read<v_rd_off(D0, 2, 0)>(vb), h2 = tr_read<v_rd_off(D0, 2, 1)>(vb), l3 = tr_read<v_rd_off(D0, 3, 0)>(vb), h3 = tr_read<v_rd_off(D0, 3, 1)>(vb);
  asm volatile("s_waitcnt lgkmcnt(0)" ::: "memory"); SBAR();
#define PK(L, H) (bf16x8){L[0], L[1], L[2], L[3], H[0], H[1], H[2], H[3]}
  od = __builtin_amdgcn_mfma_f32_32x32x16_bf16(pa0, PK(l0, h0), od, 0, 0, 0);
  od = __builtin_amdgcn_mfma_f32_32x32x16_bf16(pa1, PK(l1, h1), od, 0, 0, 0);
  od = __builtin_amdgcn_mfma_f32_32x32x16_bf16(pa2, PK(l2, h2), od, 0, 0, 0);
  od = __builtin_amdgcn_mfma_f32_32x32x16_bf16(pa3, PK(l3, h3), od, 0, 0, 0);
#undef PK
}
__device__ __forceinline__ void pv_d0(f32x16* o, int vb, bf16x8 pa0, bf16x8 pa1, bf16x8 pa2, bf16x8 pa3) {
  pv_one<0>(o[0], vb, pa0, pa1, pa2, pa3); pv_one<1>(o[1], vb, pa0, pa1, pa2, pa3); pv_one<2>(o[2], vb, pa0, pa1, pa2, pa3); pv_one<3>(o[3], vb, pa0, pa1, pa2, pa3);
}

template <int DQK, int SDEPTH, int ldq, int ldk, int ldv, int ldo>
__device__ __forceinline__ void attn_body(const bf16_t* __restrict__ Qb, const bf16_t* __restrict__ Kh, const bf16_t* __restrict__ KRh,
                                          const bf16_t* __restrict__ Vh, bf16_t* __restrict__ Ob, int seq,
                                          const float* __restrict__ cs, const float* __restrict__ sn, char* lds) {
  constexpr bool ROPE = DQK == 192; constexpr int ND0 = DQK / 16;
  const int tid = fresh_tid(), wid = tid >> 6, lane = tid & 63, r32 = lane & 31, hi = lane >> 5;
  char* V_lds = lds + OFF_V; char* K_lds = lds + OFF_K; char* KR_lds = lds + OFF_KR;
  float* ws = (float*)(lds + OFF_WS) + wid * 64; float* li_l = ws; float* al_l = ws + 32;
  float m_reg = -1e30f, l_reg = 0; f32x16 o[4] = {}; bf16x8 qr[8];
  char* qrl = lds + OFF_QR + wid * 4096 + lane * 16;
  __syncthreads();
  const bf16_t* Qw = Qb + (size_t)(wid * QBLK + r32) * ldq + hi * 8;
#pragma unroll
  for (int d0 = 0; d0 < 8; ++d0) qr[d0] = *reinterpret_cast<const bf16x8*>(Qw + d0 * 16);
  if constexpr (ROPE) {
    bf16x8 qx[4];
#pragma unroll
    for (int d0 = 0; d0 < 4; ++d0) qx[d0] = *reinterpret_cast<const bf16x8*>(Qw + 128 + d0 * 16);
    if (cs) {
      const float* cr = cs + (size_t)(wid * QBLK + r32) * 32 + hi * 8; const float* sr2 = sn + (size_t)(wid * QBLK + r32) * 32 + hi * 8;
#pragma unroll
      for (int p = 0; p < 2; ++p) {
        const f32x4 c0 = *(const f32x4*)(cr + p * 16), c1 = *(const f32x4*)(cr + p * 16 + 4), s0 = *(const f32x4*)(sr2 + p * 16), s1 = *(const f32x4*)(sr2 + p * 16 + 4);
        float x1[8], x2[8], y1[8], y2[8];
#pragma unroll
        for (int e = 0; e < 8; ++e) { x1[e] = bf2f(qx[p][e]); x2[e] = bf2f(qx[2 + p][e]); }
#pragma unroll
        for (int e = 0; e < 8; ++e) { const float c = e < 4 ? c0[e & 3] : c1[e & 3], s = e < 4 ? s0[e & 3] : s1[e & 3]; y1[e] = x1[e] * c - x2[e] * s; y2[e] = x1[e] * s + x2[e] * c; }
        u32x4 w1 = {cvtpk(y1[0], y1[1]), cvtpk(y1[2], y1[3]), cvtpk(y1[4], y1[5]), cvtpk(y1[6], y1[7])};
        u32x4 w2 = {cvtpk(y2[0], y2[1]), cvtpk(y2[2], y2[3]), cvtpk(y2[4], y2[5]), cvtpk(y2[6], y2[7])};
        qx[p] = *reinterpret_cast<bf16x8*>(&w1); qx[2 + p] = *reinterpret_cast<bf16x8*>(&w2);
      }
    }
#pragma unroll
    for (int d0 = 0; d0 < 4; ++d0) *reinterpret_cast<bf16x8*>(qrl + d0 * 1024) = qx[d0];
  }
  const int sr = tid >> 4, sc = (tid & 15) * 8, vst0 = v_st(sr, sc), vst1 = v_st(32 + sr, sc);
  const int krr = tid >> 3, krc = (tid & 7) * 8;
  const int vb0 = (int)(uintptr_t)V_lds + v_rd_base(lane);
  struct { bf16x8 vs0, vs1, ks0, ks1, kr; } sr_[SDEPTH];
#define SLOAD(i, k0) do { sr_[i].vs0 = *(const bf16x8*)(&Vh[(size_t)((k0) + sr) * ldv + sc]); sr_[i].vs1 = *(const bf16x8*)(&Vh[(size_t)((k0) + 32 + sr) * ldv + sc]); \
    sr_[i].ks0 = *(const bf16x8*)(&Kh[(size_t)((k0) + sr) * ldk + sc]); sr_[i].ks1 = *(const bf16x8*)(&Kh[(size_t)((k0) + 32 + sr) * ldk + sc]); \
    if constexpr (ROPE) sr_[i].kr = *(const bf16x8*)(&KRh[(size_t)((k0) + krr) * 64 + krc]); } while (0)
#define SWRITE(b, i) do { *(bf16x8*)(V_lds + (b) * SHM_V + vst0) = sr_[i].vs0;          \
    *(bf16x8*)(V_lds + (b) * SHM_V + vst1) = sr_[i].vs1; int kc = sc * 2;               \
    *(bf16x8*)(K_lds + (b) * SHM_K + KSWZ(sr, kc)) = sr_[i].ks0;                       \
    *(bf16x8*)(K_lds + (b) * SHM_K + KSWZ(32 + sr, kc)) = sr_[i].ks1;                  \
    if constexpr (ROPE) *(bf16x8*)(KR_lds + (b) * SHM_KR + KRSWZ(krr, krc * 2)) = sr_[i].kr; } while (0)
#define SWAIT() do { if constexpr (SDEPTH == 2) { if constexpr (ROPE) asm volatile("s_waitcnt vmcnt(5)" ::: "memory"); else asm volatile("s_waitcnt vmcnt(4)" ::: "memory"); } \
    else asm volatile("s_waitcnt vmcnt(0)" ::: "memory"); } while (0)
#define RESC(a) do { if (__any((a) < 1.f)) { if (hi == 0) al_l[r32] = (a); asm volatile("s_waitcnt lgkmcnt(0)" ::: "memory"); \
    for (int d = 0; d < 4; ++d) for (int r = 0; r < 16; ++r) o[d][r] *= al_l[crow(r, hi)]; } } while (0)
  f32x16 pA0, pA1, pB0, pB1; float mnA, mnB, alA, alB; bf16x8 pa0, pa1, pa2, pa3; const int NT = seq / KVBLK;
  constexpr int SE = 0, SO = SDEPTH - 1;
  SLOAD(SE, 0); asm volatile("s_waitcnt vmcnt(0)" ::: "memory"); SWRITE(0, SE); __syncthreads();
  qkt<DQK>(pA0, pA1, K_lds, KR_lds, qr, qrl, r32, hi); partialSM<DQK>(pA0, pA1, m_reg, mnA, alA);
  SLOAD(SO, KVBLK); if constexpr (SDEPTH == 2) { if (2 < NT) SLOAD(SE, 2 * KVBLK); }
  SWAIT(); SWRITE(1, SO); __syncthreads();
  for (int j = 1; j + 1 < NT; j += 2) {
    SBAR(); qkt<DQK>(pB0, pB1, K_lds + SHM_K, KR_lds + SHM_KR, qr, qrl, r32, hi);
    finishSM(pA0, pA1, alA, l_reg, pa0, pa1, pa2, pa3); SBAR();
    SLOAD(SO, (j + SDEPTH) * KVBLK); SBAR();
    pv_d0(o, vb0, pa0, pa1, pa2, pa3); partialSM<DQK>(pB0, pB1, m_reg, mnB, alB);
    __syncthreads(); SWAIT(); SWRITE(0, SE);
    RESC(alB); __syncthreads();
    SBAR(); qkt<DQK>(pA0, pA1, K_lds, KR_lds, qr, qrl, r32, hi);
    finishSM(pB0, pB1, alB, l_reg, pa0, pa1, pa2, pa3); SBAR();
    if (SDEPTH == 1 || j + 3 < NT) SLOAD(SE, (j + 1 + SDEPTH) * KVBLK); SBAR();
    pv_d0(o, vb0 + (int)SHM_V, pa0, pa1, pa2, pa3); partialSM<DQK>(pA0, pA1, m_reg, mnA, alA);
    __syncthreads(); SWAIT(); SWRITE(1, SO);
    RESC(alA); __syncthreads();
  }
  SBAR(); qkt<DQK>(pB0, pB1, K_lds + SHM_K, KR_lds + SHM_KR, qr, qrl, r32, hi);
  finishSM(pA0, pA1, alA, l_reg, pa0, pa1, pa2, pa3); SBAR();
  pv_d0(o, vb0, pa0, pa1, pa2, pa3); partialSM<DQK>(pB0, pB1, m_reg, mnB, alB);
  __syncthreads(); RESC(alB);
  finishSM(pB0, pB1, alB, l_reg, pa0, pa1, pa2, pa3); SBAR();
  pv_d0(o, vb0 + (int)SHM_V, pa0, pa1, pa2, pa3);
  if (hi == 0) li_l[r32] = l_reg; asm volatile("s_waitcnt lgkmcnt(0)" ::: "memory");
  __syncthreads();
  char* Wl = lds + wid * 8192 + hi * 1024 + r32 * 2;
#pragma unroll
  for (int r = 0; r < 16; r += 2) {
    const float ra = __builtin_amdgcn_rcpf(li_l[crow(r, hi)]), rb = __builtin_amdgcn_rcpf(li_l[crow(r + 1, hi)]);
#pragma unroll
    for (int d0 = 0; d0 < 4; ++d0) {
      const unsigned w = cvtpk(o[d0][r] * ra, o[d0][r + 1] * rb);
      *(unsigned short*)(Wl + crow(r, 0) * 256 + d0 * 64) = (unsigned short)(w & 0xffffu);
      *(unsigned short*)(Wl + crow(r + 1, 0) * 256 + d0 * 64) = (unsigned short)(w >> 16);
    }
    SBAR();
  }
  asm volatile("s_waitcnt lgkmcnt(0)" ::: "memory");
  bf16_t* Ow = Ob + (size_t)(wid * QBLK) * ldo;
#pragma unroll
  for (int i = 0; i < 8; ++i) { const int ch = i * 64 + lane, row = ch >> 4, c16 = ch & 15;
    const u32x4 v = *(const u32x4*)(lds + wid * 8192 + row * 256 + c16 * 16);
    *(u32x4*)(Ow + (size_t)row * ldo + c16 * 8) = v; }
#undef SLOAD
#undef SWRITE
#undef SWAIT
#undef RESC
}
#undef SBAR
}

constexpr int DM = 2048, NB = 8, SEQ = 2048, CTXL = 256, TPB = SEQ + CTXL, MT = NB * TPB;
constexpr int FF = 5632, NQKV = 6144, MLA_INP = 1280, MLA_IN = 1088;
constexpr float EPS = 1e-6f;
constexpr int NWAVES = 8;
constexpr int LDS_BYTES = 147456;
constexpr size_t MiB = 1u << 20;
constexpr size_t WS_MOD = 1 * MiB;
constexpr size_t WS_CS0 = 2 * MiB, WS_SN0 = WS_CS0 + 512 * 1024, WS_CS1 = 3 * MiB, WS_SN1 = WS_CS1 + 256 * 1024;
constexpr size_t WS_WQKV = 4 * MiB, WS_WO0 = 28 * MiB, WS_WFI0 = 36 * MiB, WS_WFI1 = 80 * MiB, WS_WFO0 = 124 * MiB, WS_WFO1 = 146 * MiB;
constexpr size_t WS_WMI = 168 * MiB, WS_WQU = 173 * MiB, WS_WKU = 176 * MiB, WS_WMO = 180 * MiB;
constexpr size_t WS_X = 188 * MiB;
constexpr size_t WS_AO = WS_X;
constexpr size_t WS_H = 332 * MiB;
constexpr size_t WS_CQN = WS_H, WS_CKVN = WS_H + 18 * MiB;
constexpr size_t WS_AN = 404 * MiB;
constexpr size_t WS_BIG = 476 * MiB;
constexpr size_t WS_KV1 = WS_BIG, WS_Q1 = WS_BIG + 144 * MiB, WS_CIN = WS_Q1, WS_KR = WS_Q1 + 108 * MiB, WS_END = WS_KR + 3 * MiB;
static_assert(WS_END <= 768 * MiB, "ws map");

#define GAS __attribute__((address_space(1)))
#define LAS __attribute__((address_space(3)))
typedef unsigned short bf16;
typedef unsigned v4u __attribute__((ext_vector_type(4)));
typedef unsigned v2u __attribute__((ext_vector_type(2)));
typedef float f32x4 __attribute__((ext_vector_type(4)));
#define LDS_WAIT() asm volatile("s_waitcnt lgkmcnt(0)" ::: "memory")
__device__ __forceinline__ unsigned pk2(float lo, float hi) { return pg8::cvt_pk_bf16(lo, hi); }
__device__ __forceinline__ float bf2f(unsigned short s) { return __uint_as_float(((unsigned)s) << 16); }
__device__ __forceinline__ float wave_sum(float v) {
#pragma unroll
    for (int o = 1; o < 64; o <<= 1) v += __shfl_xor(v, o);
    return v;
}

struct Args { const float* in[21]; float* out; unsigned char* ws; int ph_lo, ph_hi, coop, pad; };
enum { I_X = 0, I_C, I_CTX, I_CCTX, I_ADAW, I_ADAB, I_NMG, I_NFG, I_FWI, I_FWO, I_DQKV, I_DLAM, I_DSUB, I_DWO, I_MWI, I_MQG, I_MQU, I_MKG, I_MKU, I_MWO, I_FNG };

struct Frame { unsigned char* lds; unsigned char* ws; const Args* a; int tid, lane, wave, vcu, G; };

__device__ __forceinline__ void transpose_item(const float* W, int K, int N, bf16* WT, int dst_n0, int src_n0, int k0, LAS float* scr, int lane) {
#pragma unroll 8
    for (int i = 0; i < 32; ++i) { const int kk = 2 * i + (lane >> 5); scr[kk * 33 + (lane & 31)] = W[(size_t)(k0 + kk) * N + src_n0 + (lane & 31)]; }
    LDS_WAIT(); asm volatile("" ::: "memory");
    const int c = lane & 7;
#pragma unroll
    for (int j = 0; j < 4; ++j) { const int n = (lane >> 3) + 8 * j; const LAS float* s = scr + (8 * c) * 33 + n;
        v4u o; o.x = pk2(s[0 * 33], s[1 * 33]); o.y = pk2(s[2 * 33], s[3 * 33]); o.z = pk2(s[4 * 33], s[5 * 33]); o.w = pk2(s[6 * 33], s[7 * 33]);
        *(v4u*)(WT + (size_t)(dst_n0 + n) * K + k0 + 8 * c) = o; }
    LDS_WAIT(); asm volatile("" ::: "memory");
}
__device__ __forceinline__ int ffn_dst(int c) { return c < FF ? (c >> 7) * 256 + (c & 127) : ((c - FF) >> 7) * 256 + 128 + ((c - FF) & 127); }

__device__ __forceinline__ void p0_prologue(const Frame& F) {
    const Args& A = *F.a; unsigned char* ws = F.ws;
    LAS float* scr = (LAS float*)(F.lds + F.wave * 16384);
    const int gw = F.vcu * NWAVES + F.wave, NGW = F.G * NWAVES;
    constexpr int J0 = (2048 / 64) * (6144 / 32), J1 = (2048 / 64) * (2048 / 32), J2 = (2048 / 64) * (11264 / 32), J4 = (5632 / 64) * (2048 / 32),
                  J6 = (2048 / 64) * (1088 / 32), J7 = (512 / 64) * (3072 / 32), J8 = (512 / 64) * (4096 / 32), J9 = J1;
    constexpr int NITEMS = J0 + J1 + 2 * J2 + 2 * J4 + J6 + J7 + J8 + J9;
    for (int it = gw; it < NITEMS; it += NGW) {
        int r = it;
        if (r < J0) { const int nb = r % (6144 / 32), kb = r / (6144 / 32); transpose_item(A.in[I_DQKV], 2048, 6144, (bf16*)(ws + WS_WQKV), nb * 32, nb * 32, kb * 64, scr, F.lane); continue; } r -= J0;
        if (r < J1) { const int nb = r % 64, kb = r / 64; transpose_item(A.in[I_DWO], 2048, 2048, (bf16*)(ws + WS_WO0), nb * 32, nb * 32, kb * 64, scr, F.lane); continue; } r -= J1;
        if (r < 2 * J2) { const int l = r / J2; r -= l * J2; const int nb = r % 352, kb = r / 352;
            transpose_item(A.in[I_FWI] + (size_t)l * 2048 * 11264, 2048, 11264, (bf16*)(ws + (l ? WS_WFI1 : WS_WFI0)), ffn_dst(nb * 32), nb * 32, kb * 64, scr, F.lane); continue; } r -= 2 * J2;
        if (r < 2 * J4) { const int l = r / J4; r -= l * J4; const int nb = r % 64, kb = r / 64;
            transpose_item(A.in[I_FWO] + (size_t)l * 5632 * 2048, 5632, 2048, (bf16*)(ws + (l ? WS_WFO1 : WS_WFO0)), nb * 32, nb * 32, kb * 64, scr, F.lane); continue; } r -= 2 * J4;
        if (r < J6) { const int nb = r % 34, kb = r / 34; transpose_item(A.in[I_MWI], 2048, 1088, (bf16*)(ws + WS_WMI), nb * 32, nb * 32, kb * 64, scr, F.lane); continue; } r -= J6;
        if (r < J7) { const int nb = r % 96, kb = r / 96; transpose_item(A.in[I_MQU], 512, 3072, (bf16*)(ws + WS_WQU), nb * 32, nb * 32, kb * 64, scr, F.lane); continue; } r -= J7;
        if (r < J8) { const int nb = r % 128, kb = r / 128; transpose_item(A.in[I_MKU], 512, 4096, (bf16*)(ws + WS_WKU), nb * 32, nb * 32, kb * 64, scr, F.lane); continue; } r -= J8;
        { const int nb = r % 64, kb = r / 64; transpose_item(A.in[I_MWO], 2048, 2048, (bf16*)(ws + WS_WMO), nb * 32, nb * 32, kb * 64, scr, F.lane); }
    }
    const int gt = F.vcu * 512 + F.tid, NGT = F.G * 512;
    { v4u* z = (v4u*)((bf16*)(ws + WS_WMI) + (size_t)MLA_IN * 2048); const int nz = (MLA_INP - MLA_IN) * 2048 / 8;
      for (int i = gt; i < nz; i += NGT) z[i] = (v4u){0u, 0u, 0u, 0u}; }
    for (int i = gt; i < 2048 * 96; i += NGT) {
        const bool l1 = i >= 2048 * 64; const int k = l1 ? i - 2048 * 64 : i; const int nf = l1 ? 16 : 32; const int t = k / (2 * nf), j = k % (2 * nf);
        const float pos = (float)(j < nf ? t / 64 : t % 64); const int f = j < nf ? j : j - nf;
        const float inv = exp2f(-(float)f / (float)nf * 13.287712379549449f);
        const float ang = pos * inv; double rv = (double)ang * 0.15915494309189535; rv -= floor(rv); const float rf = (float)rv;
        const float cv = __builtin_amdgcn_cosf(rf), sv = __builtin_amdgcn_sinf(rf);
        if (l1) { ((float*)(ws + WS_CS1))[k] = cv; ((float*)(ws + WS_SN1))[k] = sv; } else { ((float*)(ws + WS_CS0))[k] = cv; ((float*)(ws + WS_SN0))[k] = sv; }
    }
    __syncthreads();
    LAS float* sc = (LAS float*)F.lds; LAS float* red = (LAS float*)(F.lds + 9 * 2048 * 4);
    for (int i = F.tid; i < 9 * 2048; i += 512) { const int r = i >> 11, k = i & 2047; const float v = r < 8 ? A.in[I_C][r * 2048 + k] : A.in[I_CCTX][k]; sc[i] = v / (1.f + expf(-v)); }
    __syncthreads();
    for (int u = blockIdx.x; u < 768; u += F.G) {
        const int layer = u / 384, n0 = (u % 384) * 32, col = F.tid & 31, kg = F.tid >> 5;
        const float* w = A.in[I_ADAW] + (size_t)layer * 2048 * 12288 + (size_t)(kg * 128) * 12288 + n0 + col;
        float acc[9];
#pragma unroll
        for (int r = 0; r < 9; ++r) acc[r] = 0.f;
#pragma unroll 2
        for (int k = 0; k < 128; k += 4) {
            const float w0 = w[(size_t)(k + 0) * 12288], w1 = w[(size_t)(k + 1) * 12288], w2 = w[(size_t)(k + 2) * 12288], w3 = w[(size_t)(k + 3) * 12288];
#pragma unroll
            for (int r = 0; r < 9; ++r) { const f32x4 s = *(const LAS f32x4*)(sc + r * 2048 + kg * 128 + k); acc[r] += (s.x * w0 + s.y * w1) + (s.z * w2 + s.w * w3); }
        }
#pragma unroll
        for (int r = 0; r < 9; ++r) red[(kg * 9 + r) * 32 + col] = acc[r];
        __syncthreads();
        if (F.tid < 288) { const int r = F.tid >> 5, c2 = F.tid & 31; float s = 0.f;
#pragma unroll
            for (int g = 0; g < 16; ++g) s += red[(g * 9 + r) * 32 + c2];
            ((float*)(ws + WS_MOD))[(size_t)(layer * 9 + r) * 12288 + n0 + c2] = s + A.in[I_ADAB][layer * 12288 + n0 + c2]; }
        __syncthreads();
    }
}

__device__ __forceinline__ void norm_phase(const Frame& F, int layer, int which, bool from_input, bool lat_only) {
    const Args& A = *F.a; const int gw = F.vcu * NWAVES + F.wave, NGW = F.G * NWAVES;
    const float* g = (which ? A.in[I_NFG] : A.in[I_NMG]) + layer * 2048;
    const float* X = (const float*)(F.ws + WS_X); bf16* H = (bf16*)(F.ws + WS_H);
    for (int m = gw; m < MT; m += NGW) {
        const int b = m / TPB, r = m - b * TPB; if (lat_only && r < CTXL) continue;
        const float* src = from_input ? (r < CTXL ? A.in[I_CTX] + ((size_t)b * CTXL + r) * 2048 : A.in[I_X] + ((size_t)b * SEQ + (r - CTXL)) * 2048) : X + (size_t)m * 2048;
        const float* shift = (const float*)(F.ws + WS_MOD) + (size_t)(layer * 9 + (r < CTXL ? 8 : b)) * 12288 + which * 3 * 2048; const float* scale = shift + 2048;
        const f32x4* xr = (const f32x4*)src + F.lane;
        f32x4 v[8]; float s = 0.f;
#pragma unroll
        for (int j = 0; j < 8; ++j) { v[j] = xr[64 * j]; s += (v[j].x * v[j].x + v[j].y * v[j].y) + (v[j].z * v[j].z + v[j].w * v[j].w); }
        const float rstd = rsqrtf(wave_sum(s) * (1.f / 2048.f) + EPS);
        v2u* o8 = (v2u*)(H + (size_t)m * 2048) + F.lane;
#pragma unroll
        for (int j = 0; j < 8; ++j) { const f32x4 gg = ((const f32x4*)g)[64 * j + F.lane], sc = ((const f32x4*)scale)[64 * j + F.lane], sh = ((const f32x4*)shift)[64 * j + F.lane];
            const f32x4 y = (v[j] * rstd * gg) * (sc + 1.f) + sh; v2u w; w.x = pk2(y.x, y.y); w.y = pk2(y.z, y.w); o8[64 * j] = w; }
    }
}

__device__ __forceinline__ void rope0_phase(const Frame& F) {
    const int gw = F.vcu * NWAVES + F.wave, NGW = F.G * NWAVES;
    bf16* QKV = (bf16*)(F.ws + WS_BIG); const float* CS = (const float*)(F.ws + WS_CS0); const float* SN = (const float*)(F.ws + WS_SN0);
    for (int lr = gw; lr < NB * SEQ; lr += NGW) {
        const int b = lr >> 11, t = lr & 2047; bf16* row = QKV + ((size_t)b * TPB + CTXL + t) * NQKV;
#pragma unroll
        for (int it = 0; it < 4; ++it) { const int idx = it * 64 + F.lane, grp = idx >> 3, j0 = (idx & 7) * 8;
            v4u a = *(const v4u*)(row + grp * 128 + j0), bq = *(const v4u*)(row + grp * 128 + 64 + j0);
            const f32x4 c0 = *(const f32x4*)(CS + t * 64 + j0), c1 = *(const f32x4*)(CS + t * 64 + j0 + 4), s0 = *(const f32x4*)(SN + t * 64 + j0), s1 = *(const f32x4*)(SN + t * 64 + j0 + 4);
            v4u oa, ob;
#pragma unroll
            for (int q = 0; q < 4; ++q) {
                const float x1l = __uint_as_float(a[q] << 16), x1h = __uint_as_float(a[q] & 0xffff0000u), x2l = __uint_as_float(bq[q] << 16), x2h = __uint_as_float(bq[q] & 0xffff0000u);
                const float cl = q < 2 ? c0[2 * q] : c1[2 * q - 4], ch = q < 2 ? c0[2 * q + 1] : c1[2 * q - 3], sl = q < 2 ? s0[2 * q] : s1[2 * q - 4], sh = q < 2 ? s0[2 * q + 1] : s1[2 * q - 3];
                oa[q] = pk2(x1l * cl - x2l * sl, x1h * ch - x2h * sh); ob[q] = pk2(x1l * sl + x2l * cl, x1h * sh + x2h * ch); }
            *(v4u*)(row + grp * 128 + j0) = oa; *(v4u*)(row + grp * 128 + 64 + j0) = ob; }
    }
}

__device__ __forceinline__ void combine_phase(const Frame& F) {
    const Args& A = *F.a; const int gw = F.vcu * NWAVES + F.wave, NGW = F.G * NWAVES;
    const float* lv = A.in[I_DLAM];
    const float s1 = wave_sum(lv[F.lane] * lv[128 + F.lane] + lv[64 + F.lane] * lv[192 + F.lane]);
    const float s2 = wave_sum(lv[256 + F.lane] * lv[384 + F.lane] + lv[320 + F.lane] * lv[448 + F.lane]);
    const float lam_init = 0.2f, lam = expf(s1) - expf(s2) + lam_init;
    const f32x4 gs = ((const f32x4*)A.in[I_DSUB])[F.lane];
    const bf16* AO = (const bf16*)(F.ws + WS_AO); bf16* AN = (bf16*)(F.ws + WS_AN);
    for (int m = gw; m < MT; m += NGW) {
#pragma unroll 2
        for (int h = 0; h < 8; ++h) {
            const v2u a = *((const v2u*)(AO + (size_t)m * 4096 + (2 * h) * 256) + F.lane), bq = *((const v2u*)(AO + (size_t)m * 4096 + (2 * h + 1) * 256) + F.lane);
            f32x4 d; d.x = __uint_as_float(a.x << 16) - lam * __uint_as_float(bq.x << 16); d.y = __uint_as_float(a.x & 0xffff0000u) - lam * __uint_as_float(bq.x & 0xffff0000u);
            d.z = __uint_as_float(a.y << 16) - lam * __uint_as_float(bq.y << 16); d.w = __uint_as_float(a.y & 0xffff0000u) - lam * __uint_as_float(bq.y & 0xffff0000u);
            const float ss = wave_sum((d.x * d.x + d.y * d.y) + (d.z * d.z + d.w * d.w));
            const float rstd = rsqrtf(ss * (1.f / 256.f) + EPS) * (1.f - lam_init);
            v2u w; w.x = pk2(d.x * rstd * gs.x, d.y * rstd * gs.y); w.y = pk2(d.z * rstd * gs.z, d.w * rstd * gs.w);
            *((v2u*)(AN + (size_t)m * 2048 + h * 256) + F.lane) = w;
        }
    }
}

__device__ __forceinline__ void mla_norm_phase(const Frame& F) {
    const Args& A = *F.a; const int gw = F.vcu * NWAVES + F.wave, NGW = F.G * NWAVES;
    const bf16* CIN = (const bf16*)(F.ws + WS_CIN); bf16* CQN = (bf16*)(F.ws + WS_CQN); bf16* CKVN = (bf16*)(F.ws + WS_CKVN); bf16* KR = (bf16*)(F.ws + WS_KR);
    const float* CS = (const float*)(F.ws + WS_CS1); const float* SN = (const float*)(F.ws + WS_SN1);
    const f32x4 gq0 = ((const f32x4*)A.in[I_MQG])[2 * F.lane], gq1 = ((const f32x4*)A.in[I_MQG])[2 * F.lane + 1];
    const f32x4 gk0 = ((const f32x4*)A.in[I_MKG])[2 * F.lane], gk1 = ((const f32x4*)A.in[I_MKG])[2 * F.lane + 1];
    for (int m = gw; m < MT; m += NGW) {
        const bf16* row = CIN + (size_t)m * MLA_INP;
#pragma unroll
        for (int p = 0; p < 2; ++p) {
            const v4u a = *((const v4u*)(row + p * 512) + F.lane); float x[8];
#pragma unroll
            for (int q = 0; q < 4; ++q) { x[2 * q] = __uint_as_float(a[q] << 16); x[2 * q + 1] = __uint_as_float(a[q] & 0xffff0000u); }
            float s = 0.f;
#pragma unroll
            for (int e = 0; e < 8; ++e) s += x[e] * x[e];
            const float rstd = rsqrtf(wave_sum(s) * (1.f / 512.f) + EPS);
            const f32x4 g0 = p ? gk0 : gq0, g1 = p ? gk1 : gq1;
            v4u w; w.x = pk2(x[0] * rstd * g0.x, x[1] * rstd * g0.y); w.y = pk2(x[2] * rstd * g0.z, x[3] * rstd * g0.w);
            w.z = pk2(x[4] * rstd * g1.x, x[5] * rstd * g1.y); w.w = pk2(x[6] * rstd * g1.z, x[7] * rstd * g1.w);
            *((v4u*)((p ? CKVN : CQN) + (size_t)m * 512) + F.lane) = w;
        }
        const int b = m / TPB, r = m - b * TPB;
        if (F.lane < 4) {
            const v4u a = *((const v4u*)(row + 1024) + F.lane), bq = *((const v4u*)(row + 1024 + 32) + F.lane);
            v4u oa = a, ob = bq;
            if (r >= CTXL) { const int t = r - CTXL, j0 = F.lane * 8;
                const f32x4 c0 = *(const f32x4*)(CS + t * 32 + j0), c1 = *(const f32x4*)(CS + t * 32 + j0 + 4), s0 = *(const f32x4*)(SN + t * 32 + j0), s1 = *(const f32x4*)(SN + t * 32 + j0 + 4);
#pragma unroll
                for (int q = 0; q < 4; ++q) {
                    const float x1l = __uint_as_float(a[q] << 16), x1h = __uint_as_float(a[q] & 0xffff0000u), x2l = __uint_as_float(bq[q] << 16), x2h = __uint_as_float(bq[q] & 0xffff0000u);
                    const float cl = q < 2 ? c0[2 * q] : c1[2 * q - 4], ch = q < 2 ? c0[2 * q + 1] : c1[2 * q - 3], sl = q < 2 ? s0[2 * q] : s1[2 * q - 4], sh = q < 2 ? s0[2 * q + 1] : s1[2 * q - 3];
                    oa[q] = pk2(x1l * cl - x2l * sl, x1h * ch - x2h * sh); ob[q] = pk2(x1l * sl + x2l * cl, x1h * sh + x2h * ch); } }
            *((v4u*)(KR + (size_t)m * 64) + F.lane) = oa; *((v4u*)(KR + (size_t)m * 64 + 32) + F.lane) = ob;
        }
    }
}

__device__ __forceinline__ void final_phase(const Frame& F) {
    const Args& A = *F.a; const int gw = F.vcu * NWAVES + F.wave, NGW = F.G * NWAVES;
    const float* X = (const float*)(F.ws + WS_X); const float* g = A.in[I_FNG];
    for (int lr = gw; lr < NB * SEQ; lr += NGW) {
        const int b = lr >> 11, t = lr & 2047; const f32x4* xr = (const f32x4*)(X + ((size_t)b * TPB + CTXL + t) * 2048) + F.lane;
        f32x4 v[8]; float s = 0.f;
#pragma unroll
        for (int j = 0; j < 8; ++j) { v[j] = xr[64 * j]; s += (v[j].x * v[j].x + v[j].y * v[j].y) + (v[j].z * v[j].z + v[j].w * v[j].w); }
        const float rstd = rsqrtf(wave_sum(s) * (1.f / 2048.f) + EPS);
        f32x4* o = (f32x4*)(A.out + (size_t)lr * 2048) + F.lane;
#pragma unroll
        for (int j = 0; j < 8; ++j) o[64 * j] = v[j] * rstd * ((const f32x4*)g)[64 * j + F.lane];
    }
}

__device__ __forceinline__ void attn0_phase(const Frame& F) {
    const bf16* QKV = (const bf16*)(F.ws + WS_BIG); bf16* AO = (bf16*)(F.ws + WS_AO);
    for (int li = F.vcu; li < 2048 + 256; li += F.G) {
        int b, mp, vh, qrow0, seq;
        if (li < 2048) { const int qb = li & 7; vh = (li >> 3) & 1; mp = (li >> 4) & 15; b = li >> 8; qrow0 = b * TPB + CTXL + qb * 256; seq = TPB; }
        else { const int ci = li - 2048; vh = ci & 1; mp = (ci >> 1) & 15; b = ci >> 5; qrow0 = b * TPB; seq = CTXL; }
        const bf16* kb = QKV + (size_t)b * TPB * NQKV;
        att::attn_body<128, ATT0_SDEPTH, NQKV, NQKV, NQKV, 4096>(QKV + (size_t)qrow0 * NQKV + mp * 128, kb + 2048 + mp * 128, nullptr, kb + 4096 + (mp >> 1) * 256 + vh * 128,
                               AO + (size_t)qrow0 * 4096 + mp * 256 + vh * 128, seq, nullptr, nullptr, (char*)F.lds);
    }
}
__device__ __forceinline__ void attn1_phase(const Frame& F) {
    const bf16* Q1 = (const bf16*)(F.ws + WS_Q1); const bf16* KV1 = (const bf16*)(F.ws + WS_KV1); const bf16* KR = (const bf16*)(F.ws + WS_KR); bf16* AN = (bf16*)(F.ws + WS_AN);
    const float* CS = (const float*)(F.ws + WS_CS1); const float* SN = (const float*)(F.ws + WS_SN1);
    for (int li = F.vcu; li < 1024; li += F.G) {
        const int qb = li & 7, h = (li >> 3) & 15, b = li >> 7; const int qrow0 = b * TPB + CTXL + qb * 256;
        const bf16* kb = KV1 + (size_t)b * TPB * 4096 + h * 256;
        att::attn_body<192, ATT1_SDEPTH, 3072, 4096, 4096, 2048>(Q1 + (size_t)qrow0 * 3072 + h * 192, kb, KR + (size_t)b * TPB * 64, kb + 128,
                                         AN + (size_t)qrow0 * 2048 + h * 128, TPB, CS + (size_t)qb * 256 * 32, SN + (size_t)qb * 256 * 32, (char*)F.lds);
    }
}

__device__ __forceinline__ void grid_bar(unsigned* ctr, unsigned target) {
    asm volatile("s_waitcnt vmcnt(0)" ::: "memory");
    __syncthreads();
    if (threadIdx.x == 0) {
        __builtin_amdgcn_fence(__ATOMIC_RELEASE, "agent");
        asm volatile("s_waitcnt vmcnt(0)" ::: "memory");
        __hip_atomic_fetch_add(ctr, 1u, __ATOMIC_RELAXED, __HIP_MEMORY_SCOPE_AGENT);
        while (__hip_atomic_load(ctr, __ATOMIC_RELAXED, __HIP_MEMORY_SCOPE_AGENT) < target) __builtin_amdgcn_s_sleep(2);
        __builtin_amdgcn_fence(__ATOMIC_ACQUIRE, "agent");
        asm volatile("s_waitcnt vmcnt(0)" ::: "memory");
    }
    __syncthreads();
}
constexpr int NPH = 20;
__global__ void __launch_bounds__(NWAVES * 64, 2) fwd_mega(Args args) {
    extern __shared__ __attribute__((aligned(16))) unsigned char lds[];
    Frame F; F.lds = lds; F.ws = args.ws; F.a = &args;
#define REFRESH() do { F.tid = fresh_tid(); F.lane = F.tid & 63; F.wave = __builtin_amdgcn_readfirstlane(F.tid >> 6); } while (0)
    REFRESH();
    F.G = gridDim.x; { const int bx = blockIdx.x; F.vcu = (F.G % 8 == 0) ? (bx % 8) * (F.G / 8) + bx / 8 : bx; }
    const int lo = args.ph_lo, hi = args.ph_hi;
    unsigned char* ws = args.ws; float* MOD = (float*)(ws + WS_MOD);
    PG8_LAS unsigned char* glds = (PG8_LAS unsigned char*)lds;
#define IN(k) (lo <= (k) && (k) < hi)
#define SEAM(k) do { if (IN(k) && IN((k) + 1)) grid_bar(barw, (unsigned)((k) + 1) * (unsigned)F.G); } while (0)
    unsigned* barw = (unsigned*)(ws + 256);
    if (args.coop) { if (blockIdx.x == 0 && threadIdx.x == 0) __hip_atomic_store(barw, 0u, __ATOMIC_RELAXED, __HIP_MEMORY_SCOPE_AGENT); cg::this_grid().sync(); }
#define GEMM_PHASE(EPI, Aoff, Boff, M_, N_, K_, LAT, ...) do { pg8::Gemm g{(const bf16*)(ws + (Aoff)), (const bf16*)(ws + (Boff)), M_, N_, K_}; pg8::StaticOrder S; S.init(M_, N_, F.G, (int)blockIdx.x, LAT); \
        pg8::EPI E{__VA_ARGS__}; pg8::gemm_phase<pg8::EPI, pg8::StaticOrder, true, true>(glds, g, S, E); } while (0)

    if (IN(0)) { REFRESH(); p0_prologue(F); } SEAM(0);
    if (IN(1)) { REFRESH(); norm_phase(F, 0, 0, true, false); } SEAM(1);
    if (IN(2)) { GEMM_PHASE(EpiBf16, WS_H, WS_WQKV, MT, NQKV, 2048, 0, (bf16*)(ws + WS_BIG), NQKV); } SEAM(2);
    if (IN(3)) { REFRESH(); rope0_phase(F); } SEAM(3);
    if (IN(4)) { REFRESH(); attn0_phase(F); } SEAM(4);
    if (IN(5)) { REFRESH(); combine_phase(F); } SEAM(5);
    if (IN(6)) { GEMM_PHASE(EpiRes, WS_AN, WS_WO0, MT, 2048, 2048, 0, (float*)(ws + WS_X), args.in[I_X], args.in[I_CTX], MOD + 2 * 2048); } SEAM(6);
    if (IN(7)) { REFRESH(); norm_phase(F, 0, 1, false, false); } SEAM(7);
    if (IN(8)) { GEMM_PHASE(EpiSwiGLU, WS_H, WS_WFI0, MT, 2 * FF, 2048, 0, (bf16*)(ws + WS_BIG), FF); } SEAM(8);
    if (IN(9)) { GEMM_PHASE(EpiRes, WS_BIG, WS_WFO0, MT, 2048, FF, 0, (float*)(ws + WS_X), nullptr, nullptr, MOD + 5 * 2048); } SEAM(9);
    if (IN(10)) { REFRESH(); norm_phase(F, 1, 0, false, false); } SEAM(10);
    if (IN(11)) { GEMM_PHASE(EpiBf16, WS_H, WS_WMI, MT, MLA_INP, 2048, 0, (bf16*)(ws + WS_CIN), MLA_INP); } SEAM(11);
    if (IN(12)) { REFRESH(); mla_norm_phase(F); } SEAM(12);
    if (IN(13)) { GEMM_PHASE(EpiBf16, WS_CKVN, WS_WKU, MT, 4096, 512, 0, (bf16*)(ws + WS_KV1), 4096);
                  GEMM_PHASE(EpiBf16, WS_CQN, WS_WQU, MT, 3072, 512, 1, (bf16*)(ws + WS_Q1), 3072); } SEAM(13);
    if (IN(14)) { REFRESH(); attn1_phase(F); } SEAM(14);
    if (IN(15)) { GEMM_PHASE(EpiRes, WS_AN, WS_WMO, MT, 2048, 2048, 1, (float*)(ws + WS_X), nullptr, nullptr, MOD + 9 * 12288 + 2 * 2048); } SEAM(15);
    if (IN(16)) { REFRESH(); norm_phase(F, 1, 1, false, true); } SEAM(16);
    if (IN(17)) { GEMM_PHASE(EpiSwiGLU, WS_H, WS_WFI1, MT, 2 * FF, 2048, 1, (bf16*)(ws + WS_BIG), FF); } SEAM(17);
    if (IN(18)) { GEMM_PHASE(EpiRes, WS_BIG, WS_WFO1, MT, 2048, FF, 1, (float*)(ws + WS_X), nullptr, nullptr, MOD + 9 * 12288 + 5 * 2048); } SEAM(18);
    if (IN(19)) { REFRESH(); final_phase(F); }
#undef IN
#undef SEAM
#undef GEMM_PHASE
}

extern "C" void kernel_launch(void* const* d_in, const int* in_sizes, int n_in, void* d_out, int out_size, void* d_ws, size_t ws_size, hipStream_t stream) {
    static int grid = 0;
    if (grid == 0) {
        if (n_in != 21 || in_sizes[0] != NB * SEQ * DM || out_size != NB * SEQ * DM || ws_size < WS_END) {
            fprintf(stderr, "kernel_launch: shape mismatch (n_in %d in0 %d out %d ws %zu, need ws >= %zu); nothing launched\n", n_in, n_in > 0 ? in_sizes[0] : -1, out_size, ws_size, (size_t)WS_END); grid = -1; return; }
        int dev = 0, cus = 0, per_cu = 0;
        if (hipGetDevice(&dev) != hipSuccess || hipDeviceGetAttribute(&cus, hipDeviceAttributeMultiprocessorCount, dev) != hipSuccess) { fprintf(stderr, "kernel_launch: device query failed\n"); grid = -1; return; }
        if (hipFuncSetAttribute((const void*)fwd_mega, hipFuncAttributeMaxDynamicSharedMemorySize, LDS_BYTES) != hipSuccess) { fprintf(stderr, "kernel_launch: hipFuncSetAttribute failed\n"); grid = -1; return; }
        if (hipOccupancyMaxActiveBlocksPerMultiprocessor(&per_cu, (const void*)fwd_mega, NWAVES * 64, LDS_BYTES) != hipSuccess || per_cu < 1) { fprintf(stderr, "kernel_launch: occupancy query says %d\n", per_cu); per_cu = 1; }
        (void)hipGetLastError();
        grid = cus * 1;
    }
    if (grid < 0) return;
    Args a{};
    for (int i = 0; i < 21; ++i) a.in[i] = (const float*)d_in[i];
    a.out = (float*)d_out; a.ws = (unsigned char*)d_ws;
#if ONE_LAUNCH
    a.ph_lo = 0; a.ph_hi = NPH; a.coop = 1;
    void* kargs[] = {&a};
    hipError_t e = hipLaunchCooperativeKernel((const void*)fwd_mega, dim3(grid), dim3(NWAVES * 64), kargs, LDS_BYTES, stream);
    if (e != hipSuccess) fprintf(stderr, "kernel_launch: cooperative launch failed: %s (grid %d)\n", hipGetErrorString(e), grid);
#else
    for (int p = 0; p < NPH; ++p) {
        a.ph_lo = p; a.ph_hi = p + 1;
        hipLaunchKernelGGL(fwd_mega, dim3(grid), dim3(NWAVES * 64), LDS_BYTES, stream, a);
        const hipError_t le = hipPeekAtLastError();
        if (le != hipSuccess) { fprintf(stderr, "kernel_launch: launch %d failed: %s\n", p, hipGetErrorName(le)); break; }
    }
#endif
}
```

```cpp
#define ONE_LAUNCH 1
#define ATT1_SDEPTH 1
#define ATT0_SDEPTH 2
#include <hip/hip_runtime.h>
#include <hip/hip_cooperative_groups.h>
#include <cstdio>
#include <cstdint>
namespace cg = cooperative_groups;
__device__ __forceinline__ int fresh_tid() { int t = threadIdx.x; asm volatile("" : "+v"(t)); return t & 511; }

#ifndef ONE_LAUNCH
#define ONE_LAUNCH 1
#endif

namespace pg8 {
#define PG8_LAS __attribute__((address_space(3)))
typedef unsigned short bf16_t;
typedef short bf16x8 __attribute__((ext_vector_type(8)));
typedef float f32x4 __attribute__((ext_vector_type(4)));
typedef unsigned u32x4 __attribute__((ext_vector_type(4)));
constexpr int BM = 256, BK = 64, HALF = 128, HTB = HALF * BK * 2  , STAGE_BYTES = 8 * HTB, NXCD = 8, WGM = 8;

__host__ __device__ __forceinline__ int lds_byte(int r, int c) { const int st = (r >> 4) * 2 + (c >> 5), rr = r & 15, cc = c & 31, ob = rr * 64 + cc * 2; return st * 1024 + (ob ^ (((ob >> 9) & 1) << 5)); }
__host__ __device__ __forceinline__ void stage_rc(int b, int& R, int& C) { const int st = b / 1024, sb = b % 1024, swz = sb ^ (((sb >> 9) & 1) << 5); R = (st >> 1) * 16 + swz / 64; C = (st & 1) * 32 + (swz % 64) / 2; }
__host__ __device__ __forceinline__ int perm32(int rho) { const int n = rho >> 4, i = rho & 15; return 8 * (i >> 2) + 4 * n + (i & 3); }

struct Unit { int pm, pn; };
struct Gemm { const bf16_t* A; const bf16_t* Bt; int M, N, K; };

struct StaticOrder {
    int nM, nN, nwg, G, c, lat;
    __host__ __device__ void init(int M, int N, int G_, int c_, int lat_only) { lat = lat_only; nM = lat_only ? (M / BM) / 9 * 8 : M / BM; nN = N / BM; nwg = nM * nN; G = G_; c = c_; }
    __host__ __device__ bool next(int i, Unit& u) const {
        const long L = (long)i * G + c; if (L >= nwg) return false;
        int wgid = (int)L; { const int q = nwg / NXCD, r = nwg % NXCD, xcd = wgid % NXCD, off = wgid / NXCD; wgid = (xcd < r ? xcd * (q + 1) : r * (q + 1) + (xcd - r) * q) + off; }
        const int nig = WGM * nN, gid = wgid / nig, fm = gid * WGM, gsz = (nM - fm) < WGM ? (nM - fm) : WGM;
        int pm = fm + ((wgid % nig) % gsz); u.pn = (wgid % nig) / gsz;
        if (lat) pm = (pm >> 3) * 9 + 1 + (pm & 7);
        u.pm = pm; return true;
    }
    __device__ __forceinline__ void a_ready(const Unit&) const {}
    __device__ __forceinline__ void done(const Unit&) const {}
};

__device__ __forceinline__ unsigned cvt_pk_bf16(float lo, float hi) { unsigned r; asm volatile("v_cvt_pk_bf16_f32 %0, %1, %2" : "=v"(r) : "v"(lo), "v"(hi)); return r; }

struct EpiBf16 {
    static constexpr bool PERM = true, AFTER_DRAIN = false;
    bf16_t* O; int ldc;
    __device__ __forceinline__ void operator()(const f32x4 (&acc)[2][2][4][2], const Unit& u, int wr, int wc, int fr, int fq) const {
        const int row0 = u.pm * BM + wr * 64 + fr; const int col0 = u.pn * BM + wc * 32 + 8 * fq;
#pragma unroll
        for (int ai = 0; ai < 2; ++ai)
#pragma unroll
            for (int m = 0; m < 4; ++m) { bf16_t* rowp = O + (size_t)(row0 + ai * HALF + m * 16) * ldc + col0;
#pragma unroll
                for (int bj = 0; bj < 2; ++bj) { const f32x4 v0 = acc[ai][bj][m][0], v1 = acc[ai][bj][m][1];
                    u32x4 w; w.x = cvt_pk_bf16(v0[0], v0[1]); w.y = cvt_pk_bf16(v0[2], v0[3]); w.z = cvt_pk_bf16(v1[0], v1[1]); w.w = cvt_pk_bf16(v1[2], v1[3]);
                    *(u32x4*)(rowp + bj * HALF) = w; } }
    }
};
struct EpiSwiGLU {
    static constexpr bool PERM = true, AFTER_DRAIN = false;
    bf16_t* O; int ldc;
    __device__ __forceinline__ float sg(float g, float u) const { return g * u * __builtin_amdgcn_rcpf(1.f + __builtin_amdgcn_exp2f(-1.4426950408889634f * g)); }
    __device__ __forceinline__ void operator()(const f32x4 (&acc)[2][2][4][2], const Unit& u, int wr, int wc, int fr, int fq) const {
        const int row0 = u.pm * BM + wr * 64 + fr; const int col0 = u.pn * HALF + wc * 32 + 8 * fq;
#pragma unroll
        for (int ai = 0; ai < 2; ++ai)
#pragma unroll
            for (int m = 0; m < 4; ++m) { bf16_t* rowp = O + (size_t)(row0 + ai * HALF + m * 16) * ldc + col0;
                const f32x4 g0 = acc[ai][0][m][0], g1 = acc[ai][0][m][1], u0 = acc[ai][1][m][0], u1 = acc[ai][1][m][1];
                u32x4 w; w.x = cvt_pk_bf16(sg(g0[0], u0[0]), sg(g0[1], u0[1])); w.y = cvt_pk_bf16(sg(g0[2], u0[2]), sg(g0[3], u0[3]));
                w.z = cvt_pk_bf16(sg(g1[0], u1[0]), sg(g1[1], u1[1])); w.w = cvt_pk_bf16(sg(g1[2], u1[2]), sg(g1[3], u1[3]));
                *(u32x4*)rowp = w; }
    }
};
struct EpiRes {
    static constexpr bool PERM = false, AFTER_DRAIN = false;
    float* X; const float* xin; const float* cin; const float* gate;
    __device__ __forceinline__ void operator()(const f32x4 (&acc)[2][2][4][2], const Unit& u, int wr, int wc, int fr, int fq) const {
        const int b = u.pm / 9, r9 = u.pm - 9 * b; const int brow = r9 == 0 ? 8 : b;
        const float* g = gate + (size_t)brow * 12288; const int col0 = u.pn * BM + wc * 32 + 4 * fq; const int rl = wr * 64 + fr;
        const float* res = xin ? (r9 == 0 ? cin + (size_t)b * 256 * 2048 : xin + ((size_t)b * 2048 + (size_t)(r9 - 1) * 256) * 2048) : X + (size_t)u.pm * BM * 2048;
        float* out = X + (size_t)u.pm * BM * 2048;
        f32x4 gv[2][2];
#pragma unroll
        for (int bj = 0; bj < 2; ++bj)
#pragma unroll
            for (int n = 0; n < 2; ++n) gv[bj][n] = *(const f32x4*)(g + col0 + bj * HALF + n * 16);
#pragma unroll
        for (int ai = 0; ai < 2; ++ai)
#pragma unroll
            for (int m = 0; m < 4; ++m) { const size_t off = (size_t)(rl + ai * HALF + m * 16) * 2048 + col0;
#pragma unroll
                for (int bj = 0; bj < 2; ++bj)
#pragma unroll
                    for (int n = 0; n < 2; ++n) { const f32x4 bs = *(const f32x4*)(res + off + bj * HALF + n * 16);
                        *(f32x4*)(out + off + bj * HALF + n * 16) = bs + gv[bj][n] * acc[ai][bj][m][n]; } }
    }
};

template <class Epi, class Sched, bool ALIGN_EPI = false, bool SP2 = false>
__device__ __forceinline__ void gemm_phase(PG8_LAS unsigned char* lds, const Gemm g, const Sched& S, const Epi& E) {
    const int tid = fresh_tid(), wid = __builtin_amdgcn_readfirstlane(tid >> 6), lane = tid & 63, wr = wid >> 2, wc = wid & 3, fr = lane & 15, fq = lane >> 4;
    const int K = g.K, nt = K / BK;
    unsigned voffA[2], voffB[2];
#pragma unroll
    for (int i = 0; i < 2; ++i) { int R, C; stage_rc(tid * 16 + i * 8192, R, C); const int Rb = Epi::PERM ? ((R & ~31) + perm32(R & 31)) : R;
        voffA[i] = (unsigned)(R * K + C) * 2u; voffB[i] = (unsigned)(Rb * K + C) * 2u; }
    const size_t kstep = (size_t)(BK * 2);
    const size_t hstep = (size_t)HALF * K * 2;
    const size_t tstep = 2 * hstep;
    const unsigned ldsw = (unsigned)wid * 1024u;
    const int aoff = lds_byte(wr * 64 + fr, fq * 8), boff = lds_byte(wc * 32 + fr, fq * 8);
#define PG8_SA(b, h) (((b) * 2 + (h)) * HTB)
#define PG8_SB(b, h) ((4 + (b) * 2 + (h)) * HTB)
#define PG8_STAGE(bufoff, gbase, voff) do { _Pragma("unroll") for (int _i = 0; _i < 2; ++_i) \
        __builtin_amdgcn_global_load_lds((const unsigned*)((const char*)(gbase) + (voff)[_i]), (PG8_LAS unsigned*)(lds + (bufoff) + ldsw + _i * 8192), 16, 0, 0); } while (0)
#define PG8_LDA(dst, b, h) do { _Pragma("unroll") for (int m = 0; m < 4; ++m) _Pragma("unroll") for (int k = 0; k < 2; ++k) dst[m][k] = *(const PG8_LAS bf16x8*)(lds + PG8_SA(b, h) + aoff + m * 2048 + k * 1024); } while (0)
#define PG8_LDB(dst, b, h) do { _Pragma("unroll") for (int n = 0; n < 2; ++n) _Pragma("unroll") for (int k = 0; k < 2; ++k) dst[n][k] = *(const PG8_LAS bf16x8*)(lds + PG8_SB(b, h) + boff + n * 2048 + k * 1024); } while (0)
#define PG8_MMA(ai, bj, At, Bt) do { __builtin_amdgcn_s_setprio(1); _Pragma("unroll") for (int m = 0; m < 4; ++m) _Pragma("unroll") for (int n = 0; n < 2; ++n) _Pragma("unroll") for (int k = 0; k < 2; ++k) \
        acc[ai][bj][m][n] = __builtin_amdgcn_mfma_f32_16x16x32_bf16(Bt[n][k], At[m][k], acc[ai][bj][m][n], 0, 0, 0); __builtin_amdgcn_s_setprio(0); } while (0)
#define PG8_WAIT_V(n) asm volatile("s_waitcnt vmcnt(" #n ")" ::: "memory")
#define PG8_WAIT_L(n) asm volatile("s_waitcnt lgkmcnt(" #n ")" ::: "memory")
#define PG8_BAR __builtin_amdgcn_s_barrier()
#define PG8_SCHED __builtin_amdgcn_sched_barrier(0)
    Unit cur, nxt; int ui = 0;
    if (!S.next(0, cur)) return;
    f32x4 acc[2][2][4][2];
#pragma unroll
    for (int a = 0; a < 2; ++a)
#pragma unroll
        for (int b = 0; b < 2; ++b)
#pragma unroll
            for (int m = 0; m < 4; ++m)
#pragma unroll
                for (int n = 0; n < 2; ++n) acc[a][b][m][n] = (f32x4){0.f, 0.f, 0.f, 0.f};
    bf16x8 At[4][2], B0[2][2], B1[2][2];
    const char* cA = (const char*)g.A + (size_t)cur.pm * tstep; const char* cB = (const char*)g.Bt + (size_t)cur.pn * tstep;
    S.a_ready(cur);
    if constexpr (SP2) {
        PG8_STAGE(PG8_SB(0, 0), cB, voffB); PG8_STAGE(PG8_SB(0, 1), cB + hstep, voffB); PG8_STAGE(PG8_SA(0, 0), cA, voffA); PG8_STAGE(PG8_SA(0, 1), cA + hstep, voffA);
        if (wr == 1) PG8_BAR;
        PG8_WAIT_V(2); PG8_BAR;
        PG8_STAGE(PG8_SB(1, 0), cB + kstep, voffB); PG8_STAGE(PG8_SA(1, 0), cA + kstep, voffA); PG8_STAGE(PG8_SB(1, 1), cB + hstep + kstep, voffB);
        PG8_WAIT_V(6); PG8_BAR;
    } else {
        PG8_STAGE(PG8_SB(0, 0), cB, voffB); PG8_STAGE(PG8_SA(0, 0), cA, voffA); PG8_STAGE(PG8_SB(0, 1), cB + hstep, voffB); PG8_STAGE(PG8_SA(0, 1), cA + hstep, voffA);
        if (wr == 1) PG8_BAR;
        PG8_WAIT_V(4); PG8_BAR;
        PG8_STAGE(PG8_SB(1, 0), cB + kstep, voffB); PG8_STAGE(PG8_SA(1, 0), cA + kstep, voffA); PG8_STAGE(PG8_SB(1, 1), cB + hstep + kstep, voffB);
        PG8_WAIT_V(6); PG8_BAR;
    }
    for (;;) {
        const bool has_next = S.next(ui + 1, nxt);
        const char* nA = has_next ? (const char*)g.A + (size_t)nxt.pm * tstep : cA; const char* nB = has_next ? (const char*)g.Bt + (size_t)nxt.pn * tstep : cB;
        for (int t = 0; t < nt; t += 2) {
            const bool last = (t == nt - 2);
            const char* a1 = cA + (size_t)(t + 1) * kstep;
            const char* a2 = last ? nA : cA + (size_t)(t + 2) * kstep; const char* b2 = last ? nB : cB + (size_t)(t + 2) * kstep;
            const char* a3 = a2 + kstep; const char* b3 = b2 + kstep;
            if (last && has_next) S.a_ready(nxt);
            if constexpr (SP2) {
            PG8_LDB(B0, 0, 0); PG8_LDB(B1, 0, 1); PG8_SCHED; PG8_LDA(At, 0, 0); PG8_STAGE(PG8_SA(1, 1), a1 + hstep, voffA);
            PG8_WAIT_V(8); PG8_WAIT_L(0); PG8_BAR; PG8_MMA(0, 0, At, B0); PG8_MMA(0, 1, At, B1); PG8_BAR; PG8_SCHED;
            PG8_LDA(At, 0, 1); PG8_STAGE(PG8_SB(0, 0), b2, voffB); PG8_STAGE(PG8_SB(0, 1), b2 + hstep, voffB); PG8_STAGE(PG8_SA(0, 0), a2, voffA);
            PG8_WAIT_V(8); PG8_WAIT_L(0); PG8_BAR; PG8_MMA(1, 0, At, B0); PG8_MMA(1, 1, At, B1); PG8_BAR; PG8_SCHED;
            PG8_LDB(B0, 1, 0); PG8_LDB(B1, 1, 1); PG8_SCHED; PG8_LDA(At, 1, 0); PG8_STAGE(PG8_SA(0, 1), a2 + hstep, voffA);
            PG8_WAIT_V(8); PG8_WAIT_L(0); PG8_BAR; PG8_MMA(0, 0, At, B0); PG8_MMA(0, 1, At, B1); PG8_BAR; PG8_SCHED;
            PG8_LDA(At, 1, 1); PG8_STAGE(PG8_SB(1, 0), b3, voffB); PG8_STAGE(PG8_SB(1, 1), b3 + hstep, voffB); PG8_STAGE(PG8_SA(1, 0), a3, voffA);
            PG8_WAIT_V(8); PG8_WAIT_L(0); PG8_BAR; PG8_MMA(1, 0, At, B0); PG8_MMA(1, 1, At, B1); PG8_BAR; PG8_SCHED;
            } else {
            PG8_LDB(B0, 0, 0); PG8_SCHED; PG8_LDA(At, 0, 0); PG8_STAGE(PG8_SA(1, 1), a1 + hstep, voffA);
            PG8_WAIT_L(8); PG8_BAR; PG8_WAIT_L(0); PG8_MMA(0, 0, At, B0); PG8_BAR; PG8_SCHED;
            PG8_LDB(B1, 0, 1); PG8_STAGE(PG8_SB(0, 0), b2, voffB);
            PG8_BAR; PG8_WAIT_L(0); PG8_MMA(0, 1, At, B1); PG8_BAR;
            PG8_LDA(At, 0, 1); PG8_STAGE(PG8_SA(0, 0), a2, voffA);
            PG8_BAR; PG8_WAIT_L(0); PG8_MMA(1, 0, At, B0); PG8_BAR; PG8_SCHED;
            PG8_STAGE(PG8_SB(0, 1), b2 + hstep, voffB);
            PG8_WAIT_V(6); PG8_BAR; PG8_MMA(1, 1, At, B1); PG8_BAR;
            PG8_LDB(B0, 1, 0); PG8_SCHED; PG8_LDA(At, 1, 0); PG8_STAGE(PG8_SA(0, 1), a2 + hstep, voffA);
            PG8_WAIT_L(8); PG8_BAR; PG8_WAIT_L(0); PG8_MMA(0, 0, At, B0); PG8_BAR; PG8_SCHED;
            PG8_LDB(B1, 1, 1); PG8_STAGE(PG8_SB(1, 0), b3, voffB);
            PG8_BAR; PG8_WAIT_L(0); PG8_MMA(0, 1, At, B1); PG8_BAR;
            PG8_LDA(At, 1, 1); PG8_STAGE(PG8_SA(1, 0), a3, voffA);
            PG8_BAR; PG8_WAIT_L(0); PG8_MMA(1, 0, At, B0); PG8_BAR; PG8_SCHED;
            PG8_STAGE(PG8_SB(1, 1), b3 + hstep, voffB);
            PG8_WAIT_V(6); PG8_BAR; PG8_MMA(1, 1, At, B1); PG8_BAR;
            }
        }
        if constexpr (ALIGN_EPI) { if (wr == 0) PG8_BAR; }
        if constexpr (!Epi::AFTER_DRAIN) { E(acc, cur, wr, wc, fr, fq); S.done(cur); }
        if (!has_next) break;
#pragma unroll
        for (int a = 0; a < 2; ++a)
#pragma unroll
            for (int b = 0; b < 2; ++b)
#pragma unroll
                for (int m = 0; m < 4; ++m)
#pragma unroll
                    for (int n = 0; n < 2; ++n) acc[a][b][m][n] = (f32x4){0.f, 0.f, 0.f, 0.f};
        cur = nxt; cA = nA; cB = nB; ++ui;
        if constexpr (ALIGN_EPI) { if (wr == 1) PG8_BAR; }
    }
    PG8_WAIT_V(0);
    if constexpr (!ALIGN_EPI) { if (wr == 0) PG8_BAR; }
    PG8_BAR;
    if constexpr (Epi::AFTER_DRAIN) { E.fused(acc, cur, wr, wc, fr, fq, lds, wid, lane); S.done(cur); }
#undef PG8_SA
#undef PG8_SB
#undef PG8_STAGE
#undef PG8_LDA
#undef PG8_LDB
#undef PG8_MMA
#undef PG8_WAIT_V
#undef PG8_WAIT_L
#undef PG8_BAR
#undef PG8_SCHED
}
}

namespace att {
typedef unsigned short bf16_t;
using bf16x8 = __attribute__((ext_vector_type(8))) short;
using s16x4  = __attribute__((ext_vector_type(4))) short;
using f32x16 = __attribute__((ext_vector_type(16))) float;
using f32x4  = __attribute__((ext_vector_type(4))) float;
using u32x4  = __attribute__((ext_vector_type(4))) unsigned;
constexpr int NW = 8, QBLK = 32, KVBLK = 64;
constexpr float THR = 8.f;
constexpr int SHM_V = KVBLK * 128 * 2, SHM_K = KVBLK * 128 * 2, SHM_KR = KVBLK * 64 * 2;
constexpr int OFF_V = 0, OFF_K = 2 * SHM_V, OFF_KR = OFF_K + 2 * SHM_K, OFF_WS = OFF_KR + 2 * SHM_KR, OFF_QR = OFF_WS + NW * 64 * 4, ATT_LDS = OFF_QR + NW * 4096;
#define KSWZ(row, colB) ((row) * 256 + ((colB) ^ (((row) & 7) << 4)))
#define KRSWZ(row, colB) ((row) * 128 + ((colB) ^ (((row) & 7) << 4)))
#define SBAR() __builtin_amdgcn_sched_barrier(0)
__device__ __forceinline__ int crow(int r, int hi) { return (r & 3) + 8 * (r >> 2) + 4 * hi; }
__device__ __forceinline__ unsigned cvtpk(float lo, float hi) { unsigned r; asm volatile("v_cvt_pk_bf16_f32 %0, %1, %2" : "=v"(r) : "v"(lo), "v"(hi)); return r; }
__device__ __forceinline__ float bf2f(short s) { return __uint_as_float(((unsigned)(unsigned short)s) << 16); }

template <int DQK> struct SC { static constexpr float SCALE = DQK == 192 ? 0.07216878364870322f : 0.08838834764831845f; };

template <int DQK>
__device__ __forceinline__ void partialSM(f32x16& p0, f32x16& p1, float& m_reg, float& mn, float& alpha) {
  constexpr float SCALE = SC<DQK>::SCALE; constexpr float C = SCALE * 1.4426950408889634f;
  float pmax = p0[0]; for (int r = 1; r < 16; ++r) pmax = fmaxf(pmax, p0[r]); for (int r = 0; r < 16; ++r) pmax = fmaxf(pmax, p1[r]);
  { auto rr = __builtin_amdgcn_permlane32_swap(__float_as_uint(pmax), __float_as_uint(pmax), false, false);
    pmax = fmaxf(__uint_as_float(rr[0]), __uint_as_float(rr[1])); }
  if (__builtin_expect(__all(pmax - m_reg <= THR / SCALE), 1)) { mn = m_reg; alpha = 1.f; }
  else { mn = fmaxf(m_reg, pmax); alpha = __builtin_amdgcn_exp2f((m_reg - mn) * C); m_reg = mn; }
  float mnC = -mn * C;
  for (int r = 0; r < 16; ++r) p0[r] = fmaf(p0[r], C, mnC); for (int r = 0; r < 16; ++r) p1[r] = fmaf(p1[r], C, mnC);
  for (int r = 0; r < 16; ++r) p0[r] = __builtin_amdgcn_exp2f(p0[r]);
}
__device__ __forceinline__ void finishSM(f32x16& p0, f32x16& p1, float alpha, float& l_reg, bf16x8& pa0, bf16x8& pa1, bf16x8& pa2, bf16x8& pa3) {
  for (int r = 0; r < 16; ++r) p1[r] = __builtin_amdgcn_exp2f(p1[r]);
  float ps = 0; for (int r = 0; r < 16; ++r) ps += p0[r]; for (int r = 0; r < 16; ++r) ps += p1[r];
  { auto rr = __builtin_amdgcn_permlane32_swap(__float_as_uint(ps), __float_as_uint(ps), false, false);
    ps = __uint_as_float(rr[0]) + __uint_as_float(rr[1]); }
  l_reg = l_reg * alpha + ps;
#define PK4(P, BASE, OUT) do { unsigned a0 = cvtpk(P[BASE + 0], P[BASE + 1]), a1 = cvtpk(P[BASE + 2], P[BASE + 3]);   \
    unsigned b0 = cvtpk(P[BASE + 4], P[BASE + 5]), b1 = cvtpk(P[BASE + 6], P[BASE + 7]);                              \
    auto r0 = __builtin_amdgcn_permlane32_swap(a0, b0, false, false); auto r1 = __builtin_amdgcn_permlane32_swap(a1, b1, false, false); \
    u32x4 w = {r0[0], r1[0], r0[1], r1[1]}; OUT = *reinterpret_cast<bf16x8*>(&w); } while (0)
  PK4(p0, 0, pa0); PK4(p0, 8, pa1); PK4(p1, 0, pa2); PK4(p1, 8, pa3);
#undef PK4
}
template <int DQK>
__device__ __forceinline__ void qkt(f32x16& p0, f32x16& p1, const char* Ks, const char* KRs, const bf16x8* qr, const char* qrl, int r32, int hi) {
  p0 = f32x16{}; p1 = f32x16{};
#pragma unroll
  for (int d0 = 0; d0 < 8; ++d0) { int cb = (d0 * 16 + hi * 8) * 2;
    bf16x8 b0 = *reinterpret_cast<const bf16x8*>(Ks + KSWZ(r32, cb));
    bf16x8 b1 = *reinterpret_cast<const bf16x8*>(Ks + KSWZ(32 + r32, cb));
    p0 = __builtin_amdgcn_mfma_f32_32x32x16_bf16(b0, qr[d0], p0, 0, 0, 0);
    p1 = __builtin_amdgcn_mfma_f32_32x32x16_bf16(b1, qr[d0], p1, 0, 0, 0); }
  if constexpr (DQK == 192) {
#pragma unroll
    for (int d0 = 0; d0 < 4; ++d0) { int cb = (d0 * 16 + hi * 8) * 2;
      bf16x8 b0 = *reinterpret_cast<const bf16x8*>(KRs + KRSWZ(r32, cb));
      bf16x8 b1 = *reinterpret_cast<const bf16x8*>(KRs + KRSWZ(32 + r32, cb));
      const bf16x8 qx = *reinterpret_cast<const bf16x8*>(qrl + d0 * 1024);
      p0 = __builtin_amdgcn_mfma_f32_32x32x16_bf16(b0, qx, p0, 0, 0, 0);
      p1 = __builtin_amdgcn_mfma_f32_32x32x16_bf16(b1, qx, p1, 0, 0, 0); }
  }
}
__device__ __forceinline__ int v_st(int k, int c) { const int kk = (k & ~0xC) | ((k & 4) << 1) | ((k & 8) >> 1); return ((kk >> 3) * 4 + (c >> 5)) * 512 + ((kk & 7) * 32 + (c & 31)) * 2; }
__device__ __forceinline__ int v_rd_base(int lane) { return ((lane & 3) << 3) | (((lane >> 2) & 3) << 6) | (((lane >> 4) & 1) << 5) | (((lane >> 5) & 1) << 8); }
constexpr int v_rd_off(int d0, int ks, int half) { return d0 * 512 + ks * 4096 + half * 2048; }
template <int OFF> __device__ __forceinline__ s16x4 tr_read(int vb) {
  s16x4 r; asm volatile("ds_read_b64_tr_b16 %0, %1 offset:%2" : "=&v"(r) : "v"(vb), "i"(OFF) : "memory"); return r;
}
template <int D0> __device__ __forceinline__ void pv_one(f32x16& od, int vb, bf16x8 pa0, bf16x8 pa1, bf16x8 pa2, bf16x8 pa3) {
  const s16x4 l0 = tr_read<v_rd_off(D0, 0, 0)>(vb), h0 = tr_read<v_rd_off(D0, 0, 1)>(vb), l1 = tr_read<v_rd_off(D0, 1, 0)>(vb), h1 = tr_read<v_rd_off(D0, 1, 1)>(vb);
  const s16x4 l2 = tr_read<v_rd_off(D0, 2, 0)>(vb), h2 = tr_read<v_rd_off(D0, 2, 1)>(vb), l3 = tr_read<v_rd_off(D0, 3, 0)>(vb), h3 = tr_read<v_rd_off(D0, 3, 1)>(vb);
  asm volatile("s_waitcnt lgkmcnt(0)" ::: "memory"); SBAR();
#define PK(L, H) (bf16x8){L[0], L[1], L[2], L[3], H[0], H[1], H[2], H[3]}
  od = __builtin_amdgcn_mfma_f32_32x32x16_bf16(pa0, PK(l0, h0), od, 0, 0, 0);
  od = __builtin_amdgcn_mfma_f32_32x32x16_bf16(pa1, PK(l1, h1), od, 0, 0, 0);
  od = __builtin_amdgcn_mfma_f32_32x32x16_bf16(pa2, PK(l2, h2), od, 0, 0, 0);
  od = __builtin_amdgcn_mfma_f32_32x32x16_bf16(pa3, PK(l3, h3), od, 0, 0, 0);
#undef PK
}
__device__ __forceinline__ void pv_d0(f32x16* o, int vb, bf16x8 pa0, bf16x8 pa1, bf16x8 pa2, bf16x8 pa3) {
  pv_one<0>(o[0], vb, pa0, pa1, pa2, pa3); pv_one<1>(o[1], vb, pa0, pa1, pa2, pa3); pv_one<2>(o[2], vb, pa0, pa1, pa2, pa3); pv_one<3>(o[3], vb, pa0, pa1, pa2, pa3);
}

template <int DQK, int SDEPTH, int ldq, int ldk, int ldv, int ldo>
__device__ __forceinline__ void attn_body(const bf16_t* __restrict__ Qb, const bf16_t* __restrict__ Kh, const bf16_t* __restrict__ KRh,
                                          const bf16_t* __restrict__ Vh, bf16_t* __restrict__ Ob, int seq,
                                          const float* __restrict__ cs, const float* __restrict__ sn, char* lds) {
  constexpr bool ROPE = DQK == 192; constexpr int ND0 = DQK / 16;
  const int tid = fresh_tid(), wid = tid >> 6, lane = tid & 63, r32 = lane & 31, hi = lane >> 5;
  char* V_lds = lds + OFF_V; char* K_lds = lds + OFF_K; char* KR_lds = lds + OFF_KR;
  float* ws = (float*)(lds + OFF_WS) + wid * 64; float* li_l = ws; float* al_l = ws + 32;
  float m_reg = -1e30f, l_reg = 0; f32x16 o[4] = {}; bf16x8 qr[8];
  char* qrl = lds + OFF_QR + wid * 4096 + lane * 16;
  __syncthreads();
  const bf16_t* Qw = Qb + (size_t)(wid * QBLK + r32) * ldq + hi * 8;
#pragma unroll
  for (int d0 = 0; d0 < 8; ++d0) qr[d0] = *reinterpret_cast<const bf16x8*>(Qw + d0 * 16);
  if constexpr (ROPE) {
    bf16x8 qx[4];
#pragma unroll
    for (int d0 = 0; d0 < 4; ++d0) qx[d0] = *reinterpret_cast<const bf16x8*>(Qw + 128 + d0 * 16);
    if (cs) {
      const float* cr = cs + (size_t)(wid * QBLK + r32) * 32 + hi * 8; const float* sr2 = sn + (size_t)(wid * QBLK + r32) * 32 + hi * 8;
#pragma unroll
      for (int p = 0; p < 2; ++p) {
        const f32x4 c0 = *(const f32x4*)(cr + p * 16), c1 = *(const f32x4*)(cr + p * 16 + 4), s0 = *(const f32x4*)(sr2 + p * 16), s1 = *(const f32x4*)(sr2 + p * 16 + 4);
        float x1[8], x2[8], y1[8], y2[8];
#pragma unroll
        for (int e = 0; e < 8; ++e) { x1[e] = bf2f(qx[p][e]); x2[e] = bf2f(qx[2 + p][e]); }
#pragma unroll
        for (int e = 0; e < 8; ++e) { const float c = e < 4 ? c0[e & 3] : c1[e & 3], s = e < 4 ? s0[e & 3] : s1[e & 3]; y1[e] = x1[e] * c - x2[e] * s; y2[e] = x1[e] * s + x2[e] * c; }
        u32x4 w1 = {cvtpk(y1[0], y1[1]), cvtpk(y1[2], y1[3]), cvtpk(y1[4], y1[5]), cvtpk(y1[6], y1[7])};
        u32x4 w2 = {cvtpk(y2[0], y2[1]), cvtpk(y2[2], y2[3]), cvtpk(y2[4], y2[5]), cvtpk(y2[6], y2[7])};
        qx[p] = *reinterpret_cast<bf16x8*>(&w1); qx[2 + p] = *reinterpret_cast<bf16x8*>(&w2);
      }
    }
#pragma unroll
    for (int d0 = 0; d0 < 4; ++d0) *reinterpret_cast<bf16x8*>(qrl + d0 * 1024) = qx[d0];
  }
  const int sr = tid >> 4, sc = (tid & 15) * 8, vst0 = v_st(sr, sc), vst1 = v_st(32 + sr, sc);
  const int krr = tid >> 3, krc = (tid & 7) * 8;
  const int vb0 = (int)(uintptr_t)V_lds + v_rd_base(lane);
  struct { bf16x8 vs0, vs1, ks0, ks1, kr; } sr_[SDEPTH];
#define SLOAD(i, k0) do { sr_[i].vs0 = *(const bf16x8*)(&Vh[(size_t)((k0) + sr) * ldv + sc]); sr_[i].vs1 = *(const bf16x8*)(&Vh[(size_t)((k0) + 32 + sr) * ldv + sc]); \
    sr_[i].ks0 = *(const bf16x8*)(&Kh[(size_t)((k0) + sr) * ldk + sc]); sr_[i].ks1 = *(const bf16x8*)(&Kh[(size_t)((k0) + 32 + sr) * ldk + sc]); \
    if constexpr (ROPE) sr_[i].kr = *(const bf16x8*)(&KRh[(size_t)((k0) + krr) * 64 + krc]); } while (0)
#define SWRITE(b, i) do { *(bf16x8*)(V_lds + (b) * SHM_V + vst0) = sr_[i].vs0;          \
    *(bf16x8*)(V_lds + (b) * SHM_V + vst1) = sr_[i].vs1; int kc = sc * 2;               \
    *(bf16x8*)(K_lds + (b) * SHM_K + KSWZ(sr, kc)) = sr_[i].ks0;                       \
    *(bf16x8*)(K_lds + (b) * SHM_K + KSWZ(32 + sr, kc)) = sr_[i].ks1;                  \
    if constexpr (ROPE) *(bf16x8*)(KR_lds + (b) * SHM_KR + KRSWZ(krr, krc * 2)) = sr_[i].kr; } while (0)
#define SWAIT() do { if constexpr (SDEPTH == 2) { if constexpr (ROPE) asm volatile("s_waitcnt vmcnt(5)" ::: "memory"); else asm volatile("s_waitcnt vmcnt(4)" ::: "memory"); } \
    else asm volatile("s_waitcnt vmcnt(0)" ::: "memory"); } while (0)
#define RESC(a) do { if (__any((a) < 1.f)) { if (hi == 0) al_l[r32] = (a); asm volatile("s_waitcnt lgkmcnt(0)" ::: "memory"); \
    for (int d = 0; d < 4; ++d) for (int r = 0; r < 16; ++r) o[d][r] *= al_l[crow(r, hi)]; } } while (0)
  f32x16 pA0, pA1, pB0, pB1; float mnA, mnB, alA, alB; bf16x8 pa0, pa1, pa2, pa3; const int NT = seq / KVBLK;
  constexpr int SE = 0, SO = SDEPTH - 1;
  SLOAD(SE, 0); asm volatile("s_waitcnt vmcnt(0)" ::: "memory"); SWRITE(0, SE); __syncthreads();
  qkt<DQK>(pA0, pA1, K_lds, KR_lds, qr, qrl, r32, hi); partialSM<DQK>(pA0, pA1, m_reg, mnA, alA);
  SLOAD(SO, KVBLK); if constexpr (SDEPTH == 2) { if (2 < NT) SLOAD(SE, 2 * KVBLK); }
  SWAIT(); SWRITE(1, SO); __syncthreads();
  for (int j = 1; j + 1 < NT; j += 2) {
    SBAR(); qkt<DQK>(pB0, pB1, K_lds + SHM_K, KR_lds + SHM_KR, qr, qrl, r32, hi);
    finishSM(pA0, pA1, alA, l_reg, pa0, pa1, pa2, pa3); SBAR();
    SLOAD(SO, (j + SDEPTH) * KVBLK); SBAR();
    pv_d0(o, vb0, pa0, pa1, pa2, pa3); partialSM<DQK>(pB0, pB1, m_reg, mnB, alB);
    __syncthreads(); SWAIT(); SWRITE(0, SE);
    RESC(alB); __syncthreads();
    SBAR(); qkt<DQK>(pA0, pA1, K_lds, KR_lds, qr, qrl, r32, hi);
    finishSM(pB0, pB1, alB, l_reg, pa0, pa1, pa2, pa3); SBAR();
    if (SDEPTH == 1 || j + 3 < NT) SLOAD(SE, (j + 1 + SDEPTH) * KVBLK); SBAR();
    pv_d0(o, vb0 + (int)SHM_V, pa0, pa1, pa2, pa3); partialSM<DQK>(pA0, pA1, m_reg, mnA, alA);
    __syncthreads(); SWAIT(); SWRITE(1, SO);
    RESC(alA); __syncthreads();
  }
  SBAR(); qkt<DQK>(pB0, pB1, K_lds + SHM_K, KR_lds + SHM_KR, qr, qrl, r32, hi);
  finishSM(pA0, pA1, alA, l_reg, pa0, pa1, pa2, pa3); SBAR();
  pv_d0(o, vb0, pa0, pa1, pa2, pa3); partialSM<DQK>(pB0, pB1, m_reg, mnB, alB);
  __syncthreads(); RESC(alB);
  finishSM(pB0, pB1, alB, l_reg, pa0, pa1, pa2, pa3); SBAR();
  pv_d0(o, vb0 + (int)SHM_V, pa0, pa1, pa2, pa3);
  if (hi == 0) li_l[r32] = l_reg; asm volatile("s_waitcnt lgkmcnt(0)" ::: "memory");
  __syncthreads();
  char* Wl = lds + wid * 8192 + hi * 1024 + r32 * 2;
#pragma unroll
  for (int r = 0; r < 16; r += 2) {
    const float ra = __builtin_amdgcn_rcpf(li_l[crow(r, hi)]), rb = __builtin_amdgcn_rcpf(li_l[crow(r + 1, hi)]);
#pragma unroll
    for (int d0 = 0; d0 < 4; ++d0) {
      const unsigned w = cvtpk(o[d0][r] * ra, o[d0][r + 1] * rb);
      *(unsigned short*)(Wl + crow(r, 0) * 256 + d0 * 64) = (unsigned short)(w & 0xffffu);
      *(unsigned short*)(Wl + crow(r + 1, 0) * 256 + d0 * 64) = (unsigned short)(w >> 16);
    }
    SBAR();
  }
  asm volatile("s_waitcnt lgkmcnt(0)" ::: "memory");
  bf16_t* Ow = Ob + (size_t)(wid * QBLK) * ldo;
#pragma unroll
  for (int i = 0; i < 8; ++i) { const int ch = i * 64 + lane, row = ch >> 4, c16 = ch & 15;
    const u32x4 v = *(const u32x4*)(lds + wid * 8192 + row * 256 + c16 * 16);
    *(u32x4*)(Ow + (size_t)row * ldo + c16 * 8) = v; }
#undef SLOAD
#undef SWRITE
#undef SWAIT
#undef RESC
}
#undef SBAR
}

constexpr int DM = 2048, NB = 8, SEQ = 2048, CTXL = 256, TPB = SEQ + CTXL, MT = NB * TPB;
constexpr int FF = 5632, NQKV = 6144, MLA_INP = 1280, MLA_IN = 1088;
constexpr float EPS = 1e-6f;
constexpr int NWAVES = 8;
constexpr int LDS_BYTES = 147456;
constexpr size_t MiB = 1u << 20;
constexpr size_t WS_MOD = 1 * MiB;
constexpr size_t WS_CS0 = 2 * MiB, WS_SN0 = WS_CS0 + 512 * 1024, WS_CS1 = 3 * MiB, WS_SN1 = WS_CS1 + 256 * 1024;
constexpr size_t WS_WQKV = 4 * MiB, WS_WO0 = 28 * MiB, WS_WFI0 = 36 * MiB, WS_WFI1 = 80 * MiB, WS_WFO0 = 124 * MiB, WS_WFO1 = 146 * MiB;
constexpr size_t WS_WMI = 168 * MiB, WS_WQU = 173 * MiB, WS_WKU = 176 * MiB, WS_WMO = 180 * MiB;
constexpr size_t WS_X = 188 * MiB;
constexpr size_t WS_AO = WS_X;
constexpr size_t WS_H = 332 * MiB;
constexpr size_t WS_CQN = WS_H, WS_CKVN = WS_H + 18 * MiB;
constexpr size_t WS_AN = 404 * MiB;
constexpr size_t WS_BIG = 476 * MiB;
constexpr size_t WS_KV1 = WS_BIG, WS_Q1 = WS_BIG + 144 * MiB, WS_CIN = WS_Q1, WS_KR = WS_Q1 + 108 * MiB, WS_END = WS_KR + 3 * MiB;
static_assert(WS_END <= 768 * MiB, "ws map");

#define GAS __attribute__((address_space(1)))
#define LAS __attribute__((address_space(3)))
typedef unsigned short bf16;
typedef unsigned v4u __attribute__((ext_vector_type(4)));
typedef unsigned v2u __attribute__((ext_vector_type(2)));
typedef float f32x4 __attribute__((ext_vector_type(4)));
#define LDS_WAIT() asm volatile("s_waitcnt lgkmcnt(0)" ::: "memory")
__device__ __forceinline__ unsigned pk2(float lo, float hi) { return pg8::cvt_pk_bf16(lo, hi); }
__device__ __forceinline__ float bf2f(unsigned short s) { return __uint_as_float(((unsigned)s) << 16); }
__device__ __forceinline__ float wave_sum(float v) {
#pragma unroll
    for (int o = 1; o < 64; o <<= 1) v += __shfl_xor(v, o);
    return v;
}

struct Args { const float* in[21]; float* out; unsigned char* ws; int ph_lo, ph_hi, coop, pad; };
enum { I_X = 0, I_C, I_CTX, I_CCTX, I_ADAW, I_ADAB, I_NMG, I_NFG, I_FWI, I_FWO, I_DQKV, I_DLAM, I_DSUB, I_DWO, I_MWI, I_MQG, I_MQU, I_MKG, I_MKU, I_MWO, I_FNG };

struct Frame { unsigned char* lds; unsigned char* ws; const Args* a; int tid, lane, wave, vcu, G; };

__device__ __forceinline__ void transpose_item(const float* W, int K, int N, bf16* WT, int dst_n0, int src_n0, int k0, LAS float* scr, int lane) {
#pragma unroll 8
    for (int i = 0; i < 32; ++i) { const int kk = 2 * i + (lane >> 5); scr[kk * 33 + (lane & 31)] = W[(size_t)(k0 + kk) * N + src_n0 + (lane & 31)]; }
    LDS_WAIT(); asm volatile("" ::: "memory");
    const int c = lane & 7;
#pragma unroll
    for (int j = 0; j < 4; ++j) { const int n = (lane >> 3) + 8 * j; const LAS float* s = scr + (8 * c) * 33 + n;
        v4u o; o.x = pk2(s[0 * 33], s[1 * 33]); o.y = pk2(s[2 * 33], s[3 * 33]); o.z = pk2(s[4 * 33], s[5 * 33]); o.w = pk2(s[6 * 33], s[7 * 33]);
        *(v4u*)(WT + (size_t)(dst_n0 + n) * K + k0 + 8 * c) = o; }
    LDS_WAIT(); asm volatile("" ::: "memory");
}
__device__ __forceinline__ int ffn_dst(int c) { return c < FF ? (c >> 7) * 256 + (c & 127) : ((c - FF) >> 7) * 256 + 128 + ((c - FF) & 127); }

__device__ __forceinline__ void p0_prologue(const Frame& F) {
    const Args& A = *F.a; unsigned char* ws = F.ws;
    LAS float* scr = (LAS float*)(F.lds + F.wave * 16384);
    const int gw = F.vcu * NWAVES + F.wave, NGW = F.G * NWAVES;
    constexpr int J0 = (2048 / 64) * (6144 / 32), J1 = (2048 / 64) * (2048 / 32), J2 = (2048 / 64) * (11264 / 32), J4 = (5632 / 64) * (2048 / 32),
                  J6 = (2048 / 64) * (1088 / 32), J7 = (512 / 64) * (3072 / 32), J8 = (512 / 64) * (4096 / 32), J9 = J1;
    constexpr int NITEMS = J0 + J1 + 2 * J2 + 2 * J4 + J6 + J7 + J8 + J9;
    for (int it = gw; it < NITEMS; it += NGW) {
        int r = it;
        if (r < J0) { const int nb = r % (6144 / 32), kb = r / (6144 / 32); transpose_item(A.in[I_DQKV], 2048, 6144, (bf16*)(ws + WS_WQKV), nb * 32, nb * 32, kb * 64, scr, F.lane); continue; } r -= J0;
        if (r < J1) { const int nb = r % 64, kb = r / 64; transpose_item(A.in[I_DWO], 2048, 2048, (bf16*)(ws + WS_WO0), nb * 32, nb * 32, kb * 64, scr, F.lane); continue; } r -= J1;
        if (r < 2 * J2) { const int l = r / J2; r -= l * J2; const int nb = r % 352, kb = r / 352;
            transpose_item(A.in[I_FWI] + (size_t)l * 2048 * 11264, 2048, 11264, (bf16*)(ws + (l ? WS_WFI1 : WS_WFI0)), ffn_dst(nb * 32), nb * 32, kb * 64, scr, F.lane); continue; } r -= 2 * J2;
        if (r < 2 * J4) { const int l = r / J4; r -= l * J4; const int nb = r % 64, kb = r / 64;
            transpose_item(A.in[I_FWO] + (size_t)l * 5632 * 2048, 5632, 2048, (bf16*)(ws + (l ? WS_WFO1 : WS_WFO0)), nb * 32, nb * 32, kb * 64, scr, F.lane); continue; } r -= 2 * J4;
        if (r < J6) { const int nb = r % 34, kb = r / 34; transpose_item(A.in[I_MWI], 2048, 1088, (bf16*)(ws + WS_WMI), nb * 32, nb * 32, kb * 64, scr, F.lane); continue; } r -= J6;
        if (r < J7) { const int nb = r % 96, kb = r / 96; transpose_item(A.in[I_MQU], 512, 3072, (bf16*)(ws + WS_WQU), nb * 32, nb * 32, kb * 64, scr, F.lane); continue; } r -= J7;
        if (r < J8) { const int nb = r % 128, kb = r / 128; transpose_item(A.in[I_MKU], 512, 4096, (bf16*)(ws + WS_WKU), nb * 32, nb * 32, kb * 64, scr, F.lane); continue; } r -= J8;
        { const int nb = r % 64, kb = r / 64; transpose_item(A.in[I_MWO], 2048, 2048, (bf16*)(ws + WS_WMO), nb * 32, nb * 32, kb * 64, scr, F.lane); }
    }
    const int gt = F.vcu * 512 + F.tid, NGT = F.G * 512;
    { v4u* z = (v4u*)((bf16*)(ws + WS_WMI) + (size_t)MLA_IN * 2048); const int nz = (MLA_INP - MLA_IN) * 2048 / 8;
      for (int i = gt; i < nz; i += NGT) z[i] = (v4u){0u, 0u, 0u, 0u}; }
    for (int i = gt; i < 2048 * 96; i += NGT) {
        const bool l1 = i >= 2048 * 64; const int k = l1 ? i - 2048 * 64 : i; const int nf = l1 ? 16 : 32; const int t = k / (2 * nf), j = k % (2 * nf);
        const float pos = (float)(j < nf ? t / 64 : t % 64); const int f = j < nf ? j : j - nf;
        const float inv = exp2f(-(float)f / (float)nf * 13.287712379549449f);
        const float ang = pos * inv; double rv = (double)ang * 0.15915494309189535; rv -= floor(rv); const float rf = (float)rv;
        const float cv = __builtin_amdgcn_cosf(rf), sv = __builtin_amdgcn_sinf(rf);
        if (l1) { ((float*)(ws + WS_CS1))[k] = cv; ((float*)(ws + WS_SN1))[k] = sv; } else { ((float*)(ws + WS_CS0))[k] = cv; ((float*)(ws + WS_SN0))[k] = sv; }
    }
    __syncthreads();
    LAS float* sc = (LAS float*)F.lds; LAS float* red = (LAS float*)(F.lds + 9 * 2048 * 4);
    for (int i = F.tid; i < 9 * 2048; i += 512) { const int r = i >> 11, k = i & 2047; const float v = r < 8 ? A.in[I_C][r * 2048 + k] : A.in[I_CCTX][k]; sc[i] = v / (1.f + expf(-v)); }
    __syncthreads();
    for (int u = blockIdx.x; u < 768; u += F.G) {
        const int layer = u / 384, n0 = (u % 384) * 32, col = F.tid & 31, kg = F.tid >> 5;
        const float* w = A.in[I_ADAW] + (size_t)layer * 2048 * 12288 + (size_t)(kg * 128) * 12288 + n0 + col;
        float acc[9];
#pragma unroll
        for (int r = 0; r < 9; ++r) acc[r] = 0.f;
#pragma unroll 2
        for (int k = 0; k < 128; k += 4) {
            const float w0 = w[(size_t)(k + 0) * 12288], w1 = w[(size_t)(k + 1) * 12288], w2 = w[(size_t)(k + 2) * 12288], w3 = w[(size_t)(k + 3) * 12288];
#pragma unroll
            for (int r = 0; r < 9; ++r) { const f32x4 s = *(const LAS f32x4*)(sc + r * 2048 + kg * 128 + k); acc[r] += (s.x * w0 + s.y * w1) + (s.z * w2 + s.w * w3); }
        }
#pragma unroll
        for (int r = 0; r < 9; ++r) red[(kg * 9 + r) * 32 + col] = acc[r];
        __syncthreads();
        if (F.tid < 288) { const int r = F.tid >> 5, c2 = F.tid & 31; float s = 0.f;
#pragma unroll
            for (int g = 0; g < 16; ++g) s += red[(g * 9 + r) * 32 + c2];
            ((float*)(ws + WS_MOD))[(size_t)(layer * 9 + r) * 12288 + n0 + c2] = s + A.in[I_ADAB][layer * 12288 + n0 + c2]; }
        __syncthreads();
    }
}

__device__ __forceinline__ void norm_phase(const Frame& F, int layer, int which, bool from_input, bool lat_only) {
    const Args& A = *F.a; const int gw = F.vcu * NWAVES + F.wave, NGW = F.G * NWAVES;
    const float* g = (which ? A.in[I_NFG] : A.in[I_NMG]) + layer * 2048;
    const float* X = (const float*)(F.ws + WS_X); bf16* H = (bf16*)(F.ws + WS_H);
    for (int m = gw; m < MT; m += NGW) {
        const int b = m / TPB, r = m - b * TPB; if (lat_only && r < CTXL) continue;
        const float* src = from_input ? (r < CTXL ? A.in[I_CTX] + ((size_t)b * CTXL + r) * 2048 : A.in[I_X] + ((size_t)b * SEQ + (r - CTXL)) * 2048) : X + (size_t)m * 2048;
        const float* shift = (const float*)(F.ws + WS_MOD) + (size_t)(layer * 9 + (r < CTXL ? 8 : b)) * 12288 + which * 3 * 2048; const float* scale = shift + 2048;
        const f32x4* xr = (const f32x4*)src + F.lane;
        f32x4 v[8]; float s = 0.f;
#pragma unroll
        for (int j = 0; j < 8; ++j) { v[j] = xr[64 * j]; s += (v[j].x * v[j].x + v[j].y * v[j].y) + (v[j].z * v[j].z + v[j].w * v[j].w); }
        const float rstd = rsqrtf(wave_sum(s) * (1.f / 2048.f) + EPS);
        v2u* o8 = (v2u*)(H + (size_t)m * 2048) + F.lane;
#pragma unroll
        for (int j = 0; j < 8; ++j) { const f32x4 gg = ((const f32x4*)g)[64 * j + F.lane], sc = ((const f32x4*)scale)[64 * j + F.lane], sh = ((const f32x4*)shift)[64 * j + F.lane];
            const f32x4 y = (v[j] * rstd * gg) * (sc + 1.f) + sh; v2u w; w.x = pk2(y.x, y.y); w.y = pk2(y.z, y.w); o8[64 * j] = w; }
    }
}

__device__ __forceinline__ void rope0_phase(const Frame& F) {
    const int gw = F.vcu * NWAVES + F.wave, NGW = F.G * NWAVES;
    bf16* QKV = (bf16*)(F.ws + WS_BIG); const float* CS = (const float*)(F.ws + WS_CS0); const float* SN = (const float*)(F.ws + WS_SN0);
    for (int lr = gw; lr < NB * SEQ; lr += NGW) {
        const int b = lr >> 11, t = lr & 2047; bf16* row = QKV + ((size_t)b * TPB + CTXL + t) * NQKV;
#pragma unroll
        for (int it = 0; it < 4; ++it) { const int idx = it * 64 + F.lane, grp = idx >> 3, j0 = (idx & 7) * 8;
            v4u a = *(const v4u*)(row + grp * 128 + j0), bq = *(const v4u*)(row + grp * 128 + 64 + j0);
            const f32x4 c0 = *(const f32x4*)(CS + t * 64 + j0), c1 = *(const f32x4*)(CS + t * 64 + j0 + 4), s0 = *(const f32x4*)(SN + t * 64 + j0), s1 = *(const f32x4*)(SN + t * 64 + j0 + 4);
            v4u oa, ob;
#pragma unroll
            for (int q = 0; q < 4; ++q) {
                const float x1l = __uint_as_float(a[q] << 16), x1h = __uint_as_float(a[q] & 0xffff0000u), x2l = __uint_as_float(bq[q] << 16), x2h = __uint_as_float(bq[q] & 0xffff0000u);
                const float cl = q < 2 ? c0[2 * q] : c1[2 * q - 4], ch = q < 2 ? c0[2 * q + 1] : c1[2 * q - 3], sl = q < 2 ? s0[2 * q] : s1[2 * q - 4], sh = q < 2 ? s0[2 * q + 1] : s1[2 * q - 3];
                oa[q] = pk2(x1l * cl - x2l * sl, x1h * ch - x2h * sh); ob[q] = pk2(x1l * sl + x2l * cl, x1h * sh + x2h * ch); }
            *(v4u*)(row + grp * 128 + j0) = oa; *(v4u*)(row + grp * 128 + 64 + j0) = ob; }
    }
}

__device__ __forceinline__ void combine_phase(const Frame& F) {
    const Args& A = *F.a; const int gw = F.vcu * NWAVES + F.wave, NGW = F.G * NWAVES;
    const float* lv = A.in[I_DLAM];
    const float s1 = wave_sum(lv[F.lane] * lv[128 + F.lane] + lv[64 + F.lane] * lv[192 + F.lane]);
    const float s2 = wave_sum(lv[256 + F.lane] * lv[384 + F.lane] + lv[320 + F.lane] * lv[448 + F.lane]);
    const float lam_init = 0.2f, lam = expf(s1) - expf(s2) + lam_init;
    const f32x4 gs = ((const f32x4*)A.in[I_DSUB])[F.lane];
    const bf16* AO = (const bf16*)(F.ws + WS_AO); bf16* AN = (bf16*)(F.ws + WS_AN);
    for (int m = gw; m < MT; m += NGW) {
#pragma unroll 2
        for (int h = 0; h < 8; ++h) {
            const v2u a = *((const v2u*)(AO + (size_t)m * 4096 + (2 * h) * 256) + F.lane), bq = *((const v2u*)(AO + (size_t)m * 4096 + (2 * h + 1) * 256) + F.lane);
            f32x4 d; d.x = __uint_as_float(a.x << 16) - lam * __uint_as_float(bq.x << 16); d.y = __uint_as_float(a.x & 0xffff0000u) - lam * __uint_as_float(bq.x & 0xffff0000u);
            d.z = __uint_as_float(a.y << 16) - lam * __uint_as_float(bq.y << 16); d.w = __uint_as_float(a.y & 0xffff0000u) - lam * __uint_as_float(bq.y & 0xffff0000u);
            const float ss = wave_sum((d.x * d.x + d.y * d.y) + (d.z * d.z + d.w * d.w));
            const float rstd = rsqrtf(ss * (1.f / 256.f) + EPS) * (1.f - lam_init);
            v2u w; w.x = pk2(d.x * rstd * gs.x, d.y * rstd * gs.y); w.y = pk2(d.z * rstd * gs.z, d.w * rstd * gs.w);
            *((v2u*)(AN + (size_t)m * 2048 + h * 256) + F.lane) = w;
        }
    }
}

__device__ __forceinline__ void mla_norm_phase(const Frame& F) {
    const Args& A = *F.a; const int gw = F.vcu * NWAVES + F.wave, NGW = F.G * NWAVES;
    const bf16* CIN = (const bf16*)(F.ws + WS_CIN); bf16* CQN = (bf16*)(F.ws + WS_CQN); bf16* CKVN = (bf16*)(F.ws + WS_CKVN); bf16* KR = (bf16*)(F.ws + WS_KR);
    const float* CS = (const float*)(F.ws + WS_CS1); const float* SN = (const float*)(F.ws + WS_SN1);
    const f32x4 gq0 = ((const f32x4*)A.in[I_MQG])[2 * F.lane], gq1 = ((const f32x4*)A.in[I_MQG])[2 * F.lane + 1];
    const f32x4 gk0 = ((const f32x4*)A.in[I_MKG])[2 * F.lane], gk1 = ((const f32x4*)A.in[I_MKG])[2 * F.lane + 1];
    for (int m = gw; m < MT; m += NGW) {
        const bf16* row = CIN + (size_t)m * MLA_INP;
#pragma unroll
        for (int p = 0; p < 2; ++p) {
            const v4u a = *((const v4u*)(row + p * 512) + F.lane); float x[8];
#pragma unroll
            for (int q = 0; q < 4; ++q) { x[2 * q] = __uint_as_float(a[q] << 16); x[2 * q + 1] = __uint_as_float(a[q] & 0xffff0000u); }
            float s = 0.f;
#pragma unroll
            for (int e = 0; e < 8; ++e) s += x[e] * x[e];
            const float rstd = rsqrtf(wave_sum(s) * (1.f / 512.f) + EPS);
            const f32x4 g0 = p ? gk0 : gq0, g1 = p ? gk1 : gq1;
            v4u w; w.x = pk2(x[0] * rstd * g0.x, x[1] * rstd * g0.y); w.y = pk2(x[2] * rstd * g0.z, x[3] * rstd * g0.w);
            w.z = pk2(x[4] * rstd * g1.x, x[5] * rstd * g1.y); w.w = pk2(x[6] * rstd * g1.z, x[7] * rstd * g1.w);
            *((v4u*)((p ? CKVN : CQN) + (size_t)m * 512) + F.lane) = w;
        }
        const int b = m / TPB, r = m - b * TPB;
        if (F.lane < 4) {
            const v4u a = *((const v4u*)(row + 1024) + F.lane), bq = *((const v4u*)(row + 1024 + 32) + F.lane);
            v4u oa = a, ob = bq;
            if (r >= CTXL) { const int t = r - CTXL, j0 = F.lane * 8;
                const f32x4 c0 = *(const f32x4*)(CS + t * 32 + j0), c1 = *(const f32x4*)(CS + t * 32 + j0 + 4), s0 = *(const f32x4*)(SN + t * 32 + j0), s1 = *(const f32x4*)(SN + t * 32 + j0 + 4);
#pragma unroll
                for (int q = 0; q < 4; ++q) {
                    const float x1l = __uint_as_float(a[q] << 16), x1h = __uint_as_float(a[q] & 0xffff0000u), x2l = __uint_as_float(bq[q] << 16), x2h = __uint_as_float(bq[q] & 0xffff0000u);
                    const float cl = q < 2 ? c0[2 * q] : c1[2 * q - 4], ch = q < 2 ? c0[2 * q + 1] : c1[2 * q - 3], sl = q < 2 ? s0[2 * q] : s1[2 * q - 4], sh = q < 2 ? s0[2 * q + 1] : s1[2 * q - 3];
                    oa[q] = pk2(x1l * cl - x2l * sl, x1h * ch - x2h * sh); ob[q] = pk2(x1l * sl + x2l * cl, x1h * sh + x2h * ch); } }
            *((v4u*)(KR + (size_t)m * 64) + F.lane) = oa; *((v4u*)(KR + (size_t)m * 64 + 32) + F.lane) = ob;
        }
    }
}

__device__ __forceinline__ void final_phase(const Frame& F) {
    const Args& A = *F.a; const int gw = F.vcu * NWAVES + F.wave, NGW = F.G * NWAVES;
    const float* X = (const float*)(F.ws + WS_X); const float* g = A.in[I_FNG];
    for (int lr = gw; lr < NB * SEQ; lr += NGW) {
        const int b = lr >> 11, t = lr & 2047; const f32x4* xr = (const f32x4*)(X + ((size_t)b * TPB + CTXL + t) * 2048) + F.lane;
        f32x4 v[8]; float s = 0.f;
#pragma unroll
        for (int j = 0; j < 8; ++j) { v[j] = xr[64 * j]; s += (v[j].x * v[j].x + v[j].y * v[j].y) + (v[j].z * v[j].z + v[j].w * v[j].w); }
        const float rstd = rsqrtf(wave_sum(s) * (1.f / 2048.f) + EPS);
        f32x4* o = (f32x4*)(A.out + (size_t)lr * 2048) + F.lane;
#pragma unroll
        for (int j = 0; j < 8; ++j) o[64 * j] = v[j] * rstd * ((const f32x4*)g)[64 * j + F.lane];
    }
}

__device__ __forceinline__ void attn0_phase(const Frame& F) {
    const bf16* QKV = (const bf16*)(F.ws + WS_BIG); bf16* AO = (bf16*)(F.ws + WS_AO);
    for (int li = F.vcu; li < 2048 + 256; li += F.G) {
        int b, mp, vh, qrow0, seq;
        if (li < 2048) { const int qb = li & 7; vh = (li >> 3) & 1; mp = (li >> 4) & 15; b = li >> 8; qrow0 = b * TPB + CTXL + qb * 256; seq = TPB; }
        else { const int ci = li - 2048; vh = ci & 1; mp = (ci >> 1) & 15; b = ci >> 5; qrow0 = b * TPB; seq = CTXL; }
        const bf16* kb = QKV + (size_t)b * TPB * NQKV;
        att::attn_body<128, ATT0_SDEPTH, NQKV, NQKV, NQKV, 4096>(QKV + (size_t)qrow0 * NQKV + mp * 128, kb + 2048 + mp * 128, nullptr, kb + 4096 + (mp >> 1) * 256 + vh * 128,
                               AO + (size_t)qrow0 * 4096 + mp * 256 + vh * 128, seq, nullptr, nullptr, (char*)F.lds);
    }
}
__device__ __forceinline__ void attn1_phase(const Frame& F) {
    const bf16* Q1 = (const bf16*)(F.ws + WS_Q1); const bf16* KV1 = (const bf16*)(F.ws + WS_KV1); const bf16* KR = (const bf16*)(F.ws + WS_KR); bf16* AN = (bf16*)(F.ws + WS_AN);
    const float* CS = (const float*)(F.ws + WS_CS1); const float* SN = (const float*)(F.ws + WS_SN1);
    for (int li = F.vcu; li < 1024; li += F.G) {
        const int qb = li & 7, h = (li >> 3) & 15, b = li >> 7; const int qrow0 = b * TPB + CTXL + qb * 256;
        const bf16* kb = KV1 + (size_t)b * TPB * 4096 + h * 256;
        att::attn_body<192, ATT1_SDEPTH, 3072, 4096, 4096, 2048>(Q1 + (size_t)qrow0 * 3072 + h * 192, kb, KR + (size_t)b * TPB * 64, kb + 128,
                                         AN + (size_t)qrow0 * 2048 + h * 128, TPB, CS + (size_t)qb * 256 * 32, SN + (size_t)qb * 256 * 32, (char*)F.lds);
    }
}

__device__ __forceinline__ void grid_bar(unsigned* ctr, unsigned target) {
    asm volatile("s_waitcnt vmcnt(0)" ::: "memory");
    __syncthreads();
    if (threadIdx.x == 0) {
        __builtin_amdgcn_fence(__ATOMIC_RELEASE, "agent");
        asm volatile("s_waitcnt vmcnt(0)" ::: "memory");
        __hip_atomic_fetch_add(ctr, 1u, __ATOMIC_RELAXED, __HIP_MEMORY_SCOPE_AGENT);
        while (__hip_atomic_load(ctr, __ATOMIC_RELAXED, __HIP_MEMORY_SCOPE_AGENT) < target) __builtin_amdgcn_s_sleep(2);
        __builtin_amdgcn_fence(__ATOMIC_ACQUIRE, "agent");
        asm volatile("s_waitcnt vmcnt(0)" ::: "memory");
    }
    __syncthreads();
}
constexpr int NPH = 20;
__global__ void __launch_bounds__(NWAVES * 64, 2) fwd_mega(Args args) {
    extern __shared__ __attribute__((aligned(16))) unsigned char lds[];
    Frame F; F.lds = lds; F.ws = args.ws; F.a = &args;
#define REFRESH() do { F.tid = fresh_tid(); F.lane = F.tid & 63; F.wave = __builtin_amdgcn_readfirstlane(F.tid >> 6); } while (0)
    REFRESH();
    F.G = gridDim.x; { const int bx = blockIdx.x; F.vcu = (F.G % 8 == 0) ? (bx % 8) * (F.G / 8) + bx / 8 : bx; }
    const int lo = args.ph_lo, hi = args.ph_hi;
    unsigned char* ws = args.ws; float* MOD = (float*)(ws + WS_MOD);
    PG8_LAS unsigned char* glds = (PG8_LAS unsigned char*)lds;
#define IN(k) (lo <= (k) && (k) < hi)
#define SEAM(k) do { if (IN(k) && IN((k) + 1)) grid_bar(barw, (unsigned)((k) + 1) * (unsigned)F.G); } while (0)
    unsigned* barw = (unsigned*)(ws + 256);
    if (args.coop) { if (blockIdx.x == 0 && threadIdx.x == 0) __hip_atomic_store(barw, 0u, __ATOMIC_RELAXED, __HIP_MEMORY_SCOPE_AGENT); cg::this_grid().sync(); }
#define GEMM_PHASE(EPI, Aoff, Boff, M_, N_, K_, LAT, ...) do { pg8::Gemm g{(const bf16*)(ws + (Aoff)), (const bf16*)(ws + (Boff)), M_, N_, K_}; pg8::StaticOrder S; S.init(M_, N_, F.G, (int)blockIdx.x, LAT); \
        pg8::EPI E{__VA_ARGS__}; pg8::gemm_phase<pg8::EPI, pg8::StaticOrder, true, true>(glds, g, S, E); } while (0)

    if (IN(0)) { REFRESH(); p0_prologue(F); } SEAM(0);
    if (IN(1)) { REFRESH(); norm_phase(F, 0, 0, true, false); } SEAM(1);
    if (IN(2)) { GEMM_PHASE(EpiBf16, WS_H, WS_WQKV, MT, NQKV, 2048, 0, (bf16*)(ws + WS_BIG), NQKV); } SEAM(2);
    if (IN(3)) { REFRESH(); rope0_phase(F); } SEAM(3);
    if (IN(4)) { REFRESH(); attn0_phase(F); } SEAM(4);
    if (IN(5)) { REFRESH(); combine_phase(F); } SEAM(5);
    if (IN(6)) { GEMM_PHASE(EpiRes, WS_AN, WS_WO0, MT, 2048, 2048, 0, (float*)(ws + WS_X), args.in[I_X], args.in[I_CTX], MOD + 2 * 2048); } SEAM(6);
    if (IN(7)) { REFRESH(); norm_phase(F, 0, 1, false, false); } SEAM(7);
    if (IN(8)) { GEMM_PHASE(EpiSwiGLU, WS_H, WS_WFI0, MT, 2 * FF, 2048, 0, (bf16*)(ws + WS_BIG), FF); } SEAM(8);
    if (IN(9)) { GEMM_PHASE(EpiRes, WS_BIG, WS_WFO0, MT, 2048, FF, 0, (float*)(ws + WS_X), nullptr, nullptr, MOD + 5 * 2048); } SEAM(9);
    if (IN(10)) { REFRESH(); norm_phase(F, 1, 0, false, false); } SEAM(10);
    if (IN(11)) { GEMM_PHASE(EpiBf16, WS_H, WS_WMI, MT, MLA_INP, 2048, 0, (bf16*)(ws + WS_CIN), MLA_INP); } SEAM(11);
    if (IN(12)) { REFRESH(); mla_norm_phase(F); } SEAM(12);
    if (IN(13)) { GEMM_PHASE(EpiBf16, WS_CKVN, WS_WKU, MT, 4096, 512, 0, (bf16*)(ws + WS_KV1), 4096);
                  GEMM_PHASE(EpiBf16, WS_CQN, WS_WQU, MT, 3072, 512, 1, (bf16*)(ws + WS_Q1), 3072); } SEAM(13);
    if (IN(14)) { REFRESH(); attn1_phase(F); } SEAM(14);
    if (IN(15)) { GEMM_PHASE(EpiRes, WS_AN, WS_WMO, MT, 2048, 2048, 1, (float*)(ws + WS_X), nullptr, nullptr, MOD + 9 * 12288 + 2 * 2048); } SEAM(15);
    if (IN(16)) { REFRESH(); norm_phase(F, 1, 1, false, true); } SEAM(16);
    if (IN(17)) { GEMM_PHASE(EpiSwiGLU, WS_H, WS_WFI1, MT, 2 * FF, 2048, 1, (bf16*)(ws + WS_BIG), FF); } SEAM(17);
    if (IN(18)) { GEMM_PHASE(EpiRes, WS_BIG, WS_WFO1, MT, 2048, FF, 1, (float*)(ws + WS_X), nullptr, nullptr, MOD + 9 * 12288 + 5 * 2048); } SEAM(18);
    if (IN(19)) { REFRESH(); final_phase(F); }
#undef IN
#undef SEAM
#undef GEMM_PHASE
}

extern "C" void kernel_launch(void* const* d_in, const int* in_sizes, int n_in, void* d_out, int out_size, void* d_ws, size_t ws_size, hipStream_t stream) {
    static int grid = 0;
    if (grid == 0) {
        if (n_in != 21 || in_sizes[0] != NB * SEQ * DM || out_size != NB * SEQ * DM || ws_size < WS_END) {
            fprintf(stderr, "kernel_launch: shape mismatch (n_in %d in0 %d out %d ws %zu, need ws >= %zu); nothing launched\n", n_in, n_in > 0 ? in_sizes[0] : -1, out_size, ws_size, (size_t)WS_END); grid = -1; return; }
        int dev = 0, cus = 0, per_cu = 0;
        if (hipGetDevice(&dev) != hipSuccess || hipDeviceGetAttribute(&cus, hipDeviceAttributeMultiprocessorCount, dev) != hipSuccess) { fprintf(stderr, "kernel_launch: device query failed\n"); grid = -1; return; }
        if (hipFuncSetAttribute((const void*)fwd_mega, hipFuncAttributeMaxDynamicSharedMemorySize, LDS_BYTES) != hipSuccess) { fprintf(stderr, "kernel_launch: hipFuncSetAttribute failed\n"); grid = -1; return; }
        if (hipOccupancyMaxActiveBlocksPerMultiprocessor(&per_cu, (const void*)fwd_mega, NWAVES * 64, LDS_BYTES) != hipSuccess || per_cu < 1) { fprintf(stderr, "kernel_launch: occupancy query says %d\n", per_cu); per_cu = 1; }
        (void)hipGetLastError();
        grid = cus * 1;
    }
    if (grid < 0) return;
    Args a{};
    for (int i = 0; i < 21; ++i) a.in[i] = (const float*)d_in[i];
    a.out = (float*)d_out; a.ws = (unsigned char*)d_ws;
#if ONE_LAUNCH
    a.ph_lo = 0; a.ph_hi = NPH; a.coop = 1;
    void* kargs[] = {&a};
    hipError_t e = hipLaunchCooperativeKernel((const void*)fwd_mega, dim3(grid), dim3(NWAVES * 64), kargs, LDS_BYTES, stream);
    if (e != hipSuccess) fprintf(stderr, "kernel_launch: cooperative launch failed: %s (grid %d)\n", hipGetErrorString(e), grid);
#else
    for (int p = 0; p < NPH; ++p) {
        a.ph_lo = p; a.ph_hi = p + 1;
        hipLaunchKernelGGL(fwd_mega, dim3(grid), dim3(NWAVES * 64), LDS_BYTES, stream, a);
        const hipError_t le = hipPeekAtLastError();
        if (le != hipSuccess) { fprintf(stderr, "kernel_launch: launch %d failed: %s\n", p, hipGetErrorName(le)); break; }
    }
#endif
}
```

```cpp
#define ONE_LAUNCH 1
#define ATT1_SDEPTH 1
#define ATT0_SDEPTH 2
#define PROBE_MASK 0
#define ATT0_PX 1
#define GP_PROBE 0
#define PX_PROBE 0
#define PX_PROBE_BLOCK 0
#define PX_PROBE_WAVE 0
#define PX_PROBE_TILES 296.0
#define PROBE_DBL 0
#include <hip/hip_runtime.h>
#include <hip/hip_cooperative_groups.h>
#include <cstdio>
#include <cstdint>
namespace cg = cooperative_groups;
__device__ __forceinline__ int fresh_tid() { int t = threadIdx.x; asm volatile("" : "+v"(t)); return t & 511; }

#ifndef ONE_LAUNCH
#define ONE_LAUNCH 1
#endif

namespace pg8 {
#define PG8_LAS __attribute__((address_space(3)))
typedef unsigned short bf16_t;
typedef short bf16x8 __attribute__((ext_vector_type(8)));
typedef float f32x4 __attribute__((ext_vector_type(4)));
typedef unsigned u32x4 __attribute__((ext_vector_type(4)));
constexpr int BM = 256, BK = 64, HALF = 128, HTB = HALF * BK * 2  , STAGE_BYTES = 8 * HTB, NXCD = 8, WGM = 8;

__host__ __device__ __forceinline__ int lds_byte(int r, int c) { const int st = (r >> 4) * 2 + (c >> 5), rr = r & 15, cc = c & 31, ob = rr * 64 + cc * 2; return st * 1024 + (ob ^ (((ob >> 9) & 1) << 5)); }
__host__ __device__ __forceinline__ void stage_rc(int b, int& R, int& C) { const int st = b / 1024, sb = b % 1024, swz = sb ^ (((sb >> 9) & 1) << 5); R = (st >> 1) * 16 + swz / 64; C = (st & 1) * 32 + (swz % 64) / 2; }
__host__ __device__ __forceinline__ int perm32(int rho) { const int n = rho >> 4, i = rho & 15; return 8 * (i >> 2) + 4 * n + (i & 3); }

struct Unit { int pm, pn; };
struct Gemm { const bf16_t* A; const bf16_t* Bt; int M, N, K; };

struct StaticOrder {
    int nM, nN, nwg, G, c, lat;
    __host__ __device__ void init(int M, int N, int G_, int c_, int lat_only) { lat = lat_only; nM = lat_only ? (M / BM) / 9 * 8 : M / BM; nN = N / BM; nwg = nM * nN; G = G_; c = c_; }
    __host__ __device__ bool next(int i, Unit& u) const {
        const long L = (long)i * G + c; if (L >= nwg) return false;
        int wgid = (int)L; { const int q = nwg / NXCD, r = nwg % NXCD, xcd = wgid % NXCD, off = wgid / NXCD; wgid = (xcd < r ? xcd * (q + 1) : r * (q + 1) + (xcd - r) * q) + off; }
        const int nig = WGM * nN, gid = wgid / nig, fm = gid * WGM, gsz = (nM - fm) < WGM ? (nM - fm) : WGM;
        int pm = fm + ((wgid % nig) % gsz); u.pn = (wgid % nig) / gsz;
        if (lat) pm = (pm >> 3) * 9 + 1 + (pm & 7);
        u.pm = pm; return true;
    }
    __device__ __forceinline__ void a_ready(const Unit&) const {}
    __device__ __forceinline__ void done(const Unit&) const {}
};

__device__ __forceinline__ unsigned cvt_pk_bf16(float lo, float hi) { unsigned r; asm volatile("v_cvt_pk_bf16_f32 %0, %1, %2" : "=v"(r) : "v"(lo), "v"(hi)); return r; }

struct EpiBf16 {
    static constexpr bool PERM = true, AFTER_DRAIN = false;
    bf16_t* O; int ldc; const float* ss; const float* bias; int ldb;
    __device__ __forceinline__ void operator()(const f32x4 (&acc)[2][2][4][2], const Unit& u, int wr, int wc, int fr, int fq) const {
        const int row0 = u.pm * BM + wr * 64 + fr; const int col0 = u.pn * BM + wc * 32 + 8 * fq;
        const int b = u.pm / 9, r9 = u.pm - 9 * b; const float* bp = bias + (size_t)(r9 == 0 ? 8 : b) * ldb + col0;
#pragma unroll
        for (int ai = 0; ai < 2; ++ai)
#pragma unroll
            for (int m = 0; m < 4; ++m) { const int row = row0 + ai * HALF + m * 16; bf16_t* rowp = O + (size_t)row * ldc + col0;
                const float rs = ss ? __builtin_amdgcn_rsqf(ss[row] * (1.f / 2048.f) + 1e-6f) : 1.f;
#pragma unroll
                for (int bj = 0; bj < 2; ++bj) { f32x4 v0 = acc[ai][bj][m][0], v1 = acc[ai][bj][m][1];
                    if (ss) { v0 = v0 * rs + *(const f32x4*)(bp + bj * HALF); v1 = v1 * rs + *(const f32x4*)(bp + bj * HALF + 4); }
                    u32x4 w; w.x = cvt_pk_bf16(v0[0], v0[1]); w.y = cvt_pk_bf16(v0[2], v0[3]); w.z = cvt_pk_bf16(v1[0], v1[1]); w.w = cvt_pk_bf16(v1[2], v1[3]);
                    *(u32x4*)(rowp + bj * HALF) = w; } }
    }
};
struct EpiQKV {
    static constexpr bool PERM = true, AFTER_DRAIN = false;
    bf16_t* O; int ldc; const float* cs; const float* sn;
    __device__ __forceinline__ void operator()(const f32x4 (&acc)[2][2][4][2], const Unit& u, int wr, int wc, int fr, int fq) const {
        const int row0 = u.pm * BM + wr * 64 + fr; const int col0 = u.pn * BM + wc * 32 + 8 * fq;
        const int b = u.pm / 9, r9 = u.pm - 9 * b; const bool rot = r9 != 0 && u.pn < 16;
        const int t0 = (r9 - 1) * 256 + wr * 64 + fr; const int j0 = 16 * wc + 4 * fq;
#pragma unroll
        for (int ai = 0; ai < 2; ++ai)
#pragma unroll
            for (int m = 0; m < 4; ++m) { bf16_t* rowp = O + (size_t)(row0 + ai * HALF + m * 16) * ldc + col0;
                f32x4 c = {1.f, 1.f, 1.f, 1.f}, s = {0.f, 0.f, 0.f, 0.f};
                if (rot) { const int t = t0 + ai * HALF + m * 16; c = *(const f32x4*)(cs + t * 64 + j0); s = *(const f32x4*)(sn + t * 64 + j0); }
#pragma unroll
                for (int bj = 0; bj < 2; ++bj) { const f32x4 x1 = acc[ai][bj][m][0], x2 = acc[ai][bj][m][1];
                    const f32x4 v0 = x1 * c - x2 * s, v1 = x1 * s + x2 * c;
                    u32x4 w; w.x = cvt_pk_bf16(v0[0], v0[1]); w.y = cvt_pk_bf16(v0[2], v0[3]); w.z = cvt_pk_bf16(v1[0], v1[1]); w.w = cvt_pk_bf16(v1[2], v1[3]);
                    *(u32x4*)(rowp + bj * HALF) = w; } }
    }
};
struct EpiSwiGLU {
    static constexpr bool PERM = true, AFTER_DRAIN = false;
    bf16_t* O; int ldc; const float* ss; const float* bias;
    __device__ __forceinline__ float sg(float g, float u) const { return g * u * __builtin_amdgcn_rcpf(1.f + __builtin_amdgcn_exp2f(-1.4426950408889634f * g)); }
    __device__ __forceinline__ void operator()(const f32x4 (&acc)[2][2][4][2], const Unit& u, int wr, int wc, int fr, int fq) const {
        const int row0 = u.pm * BM + wr * 64 + fr; const int col0 = u.pn * HALF + wc * 32 + 8 * fq;
        const int b = u.pm / 9, r9 = u.pm - 9 * b; const float* bp = bias + (size_t)(r9 == 0 ? 8 : b) * 11264 + u.pn * BM + wc * 32 + 8 * fq;
        const f32x4 bg0 = *(const f32x4*)bp, bg1 = *(const f32x4*)(bp + 4), bu0 = *(const f32x4*)(bp + HALF), bu1 = *(const f32x4*)(bp + HALF + 4);
#pragma unroll
        for (int ai = 0; ai < 2; ++ai)
#pragma unroll
            for (int m = 0; m < 4; ++m) { const int row = row0 + ai * HALF + m * 16; bf16_t* rowp = O + (size_t)row * ldc + col0;
                const float rs = __builtin_amdgcn_rsqf(ss[row] * (1.f / 2048.f) + 1e-6f);
                const f32x4 g0 = acc[ai][0][m][0] * rs + bg0, g1 = acc[ai][0][m][1] * rs + bg1, u0 = acc[ai][1][m][0] * rs + bu0, u1 = acc[ai][1][m][1] * rs + bu1;
                u32x4 w; w.x = cvt_pk_bf16(sg(g0[0], u0[0]), sg(g0[1], u0[1])); w.y = cvt_pk_bf16(sg(g0[2], u0[2]), sg(g0[3], u0[3]));
                w.z = cvt_pk_bf16(sg(g1[0], u1[0]), sg(g1[1], u1[1])); w.w = cvt_pk_bf16(sg(g1[2], u1[2]), sg(g1[3], u1[3]));
                *(u32x4*)rowp = w; }
    }
};
struct EpiRes {
    static constexpr bool PERM = true, AFTER_DRAIN = false;
    float* X; const float* xin; const float* cin; const float* gate;
    bf16_t* H; const float* ng; const float* nscale; float* ss;
    __device__ __forceinline__ void operator()(const f32x4 (&acc)[2][2][4][2], const Unit& u, int wr, int wc, int fr, int fq) const {
        const int b = u.pm / 9, r9 = u.pm - 9 * b; const int brow = r9 == 0 ? 8 : b;
        const float* g = gate + (size_t)brow * 12288; const int col0 = u.pn * BM + wc * 32 + 8 * fq; const int rl = wr * 64 + fr;
        const float* res = xin ? (r9 == 0 ? cin + (size_t)b * 256 * 2048 : xin + ((size_t)b * 2048 + (size_t)(r9 - 1) * 256) * 2048) : X + (size_t)u.pm * BM * 2048;
        float* out = X + (size_t)u.pm * BM * 2048;
        f32x4 gv[2][2], wv[2][2];
#pragma unroll
        for (int bj = 0; bj < 2; ++bj)
#pragma unroll
            for (int n = 0; n < 2; ++n) { gv[bj][n] = *(const f32x4*)(g + col0 + bj * HALF + n * 4);
                if (H) wv[bj][n] = *(const f32x4*)(ng + col0 + bj * HALF + n * 4) * (*(const f32x4*)(nscale + (size_t)brow * 12288 + col0 + bj * HALF + n * 4) + 1.f); }
#pragma unroll
        for (int ai = 0; ai < 2; ++ai)
#pragma unroll
            for (int m = 0; m < 4; ++m) { const size_t off = (size_t)(rl + ai * HALF + m * 16) * 2048 + col0; float sq = 0.f;
#pragma unroll
                for (int bj = 0; bj < 2; ++bj) {
                    const f32x4 x0 = *(const f32x4*)(res + off + bj * HALF) + gv[bj][0] * acc[ai][bj][m][0], x1 = *(const f32x4*)(res + off + bj * HALF + 4) + gv[bj][1] * acc[ai][bj][m][1];
                    *(f32x4*)(out + off + bj * HALF) = x0; *(f32x4*)(out + off + bj * HALF + 4) = x1;
                    if (H) { const f32x4 h0 = x0 * wv[bj][0], h1 = x1 * wv[bj][1];
                        sq += ((x0[0] * x0[0] + x0[1] * x0[1]) + (x0[2] * x0[2] + x0[3] * x0[3])) + ((x1[0] * x1[0] + x1[1] * x1[1]) + (x1[2] * x1[2] + x1[3] * x1[3]));
                        u32x4 w; w.x = cvt_pk_bf16(h0[0], h0[1]); w.y = cvt_pk_bf16(h0[2], h0[3]); w.z = cvt_pk_bf16(h1[0], h1[1]); w.w = cvt_pk_bf16(h1[2], h1[3]);
                        *(u32x4*)(H + (size_t)u.pm * BM * 2048 + off + bj * HALF) = w; } }
                if (H) { sq += __shfl_xor(sq, 16); sq += __shfl_xor(sq, 32); if (fq == 0) unsafeAtomicAdd(ss + u.pm * BM + rl + ai * HALF + m * 16, sq); } }
    }
};

template <class Epi, class Sched, bool ALIGN_EPI = false, bool SP2 = false>
__device__ __forceinline__ void gemm_phase(PG8_LAS unsigned char* lds, const Gemm g, const Sched& S, const Epi& E) {
    const int tid = fresh_tid(), wid = __builtin_amdgcn_readfirstlane(tid >> 6), lane = tid & 63, wr = wid >> 2, wc = wid & 3, fr = lane & 15, fq = lane >> 4;
    const int K = g.K, nt = K / BK;
    unsigned voffA[2], voffB[2];
#pragma unroll
    for (int i = 0; i < 2; ++i) { int R, C; stage_rc(tid * 16 + i * 8192, R, C); const int Rb = Epi::PERM ? ((R & ~31) + perm32(R & 31)) : R;
        voffA[i] = (unsigned)(R * K + C) * 2u; voffB[i] = (unsigned)(Rb * K + C) * 2u; }
    const size_t kstep = (size_t)(BK * 2);
    const size_t hstep = (size_t)HALF * K * 2;
    const size_t tstep = 2 * hstep;
    const unsigned ldsw = (unsigned)wid * 1024u;
    const int aoff = lds_byte(wr * 64 + fr, fq * 8), boff = lds_byte(wc * 32 + fr, fq * 8);
#define PG8_SA(b, h) (((b) * 2 + (h)) * HTB)
#define PG8_SB(b, h) ((4 + (b) * 2 + (h)) * HTB)
#define PG8_STAGE(bufoff, gbase, voff) do { _Pragma("unroll") for (int _i = 0; _i < 2; ++_i) \
        __builtin_amdgcn_global_load_lds((const unsigned*)((const char*)(gbase) + (voff)[_i]), (PG8_LAS unsigned*)(lds + (bufoff) + ldsw + _i * 8192), 16, 0, 0); } while (0)
#define PG8_LDA(dst, b, h) do { _Pragma("unroll") for (int m = 0; m < 4; ++m) _Pragma("unroll") for (int k = 0; k < 2; ++k) dst[m][k] = *(const PG8_LAS bf16x8*)(lds + PG8_SA(b, h) + aoff + m * 2048 + k * 1024); } while (0)
#define PG8_LDB(dst, b, h) do { _Pragma("unroll") for (int n = 0; n < 2; ++n) _Pragma("unroll") for (int k = 0; k < 2; ++k) dst[n][k] = *(const PG8_LAS bf16x8*)(lds + PG8_SB(b, h) + boff + n * 2048 + k * 1024); } while (0)
#define PG8_MMA(ai, bj, At, Bt) do { __builtin_amdgcn_s_setprio(1); _Pragma("unroll") for (int m = 0; m < 4; ++m) _Pragma("unroll") for (int n = 0; n < 2; ++n) _Pragma("unroll") for (int k = 0; k < 2; ++k) \
        acc[ai][bj][m][n] = __builtin_amdgcn_mfma_f32_16x16x32_bf16(Bt[n][k], At[m][k], acc[ai][bj][m][n], 0, 0, 0); __builtin_amdgcn_s_setprio(0); } while (0)
#define PG8_WAIT_V(n) asm volatile("s_waitcnt vmcnt(" #n ")" ::: "memory")
#define PG8_WAIT_L(n) asm volatile("s_waitcnt lgkmcnt(" #n ")" ::: "memory")
#define PG8_BAR __builtin_amdgcn_s_barrier()
#define PG8_SCHED __builtin_amdgcn_sched_barrier(0)
    Unit cur, nxt; int ui = 0;
    if (!S.next(0, cur)) return;
    f32x4 acc[2][2][4][2];
#pragma unroll
    for (int a = 0; a < 2; ++a)
#pragma unroll
        for (int b = 0; b < 2; ++b)
#pragma unroll
            for (int m = 0; m < 4; ++m)
#pragma unroll
                for (int n = 0; n < 2; ++n) acc[a][b][m][n] = (f32x4){0.f, 0.f, 0.f, 0.f};
    bf16x8 At[4][2], B0[2][2], B1[2][2];
    const char* cA = (const char*)g.A + (size_t)cur.pm * tstep; const char* cB = (const char*)g.Bt + (size_t)cur.pn * tstep;
    S.a_ready(cur);
    if constexpr (SP2) {
        PG8_STAGE(PG8_SB(0, 0), cB, voffB); PG8_STAGE(PG8_SB(0, 1), cB + hstep, voffB); PG8_STAGE(PG8_SA(0, 0), cA, voffA); PG8_STAGE(PG8_SA(0, 1), cA + hstep, voffA);
        if (wr == 1) PG8_BAR;
        PG8_WAIT_V(2); PG8_BAR;
        PG8_STAGE(PG8_SB(1, 0), cB + kstep, voffB); PG8_STAGE(PG8_SA(1, 0), cA + kstep, voffA); PG8_STAGE(PG8_SB(1, 1), cB + hstep + kstep, voffB);
        PG8_WAIT_V(6); PG8_BAR;
    } else {
        PG8_STAGE(PG8_SB(0, 0), cB, voffB); PG8_STAGE(PG8_SA(0, 0), cA, voffA); PG8_STAGE(PG8_SB(0, 1), cB + hstep, voffB); PG8_STAGE(PG8_SA(0, 1), cA + hstep, voffA);
        if (wr == 1) PG8_BAR;
        PG8_WAIT_V(4); PG8_BAR;
        PG8_STAGE(PG8_SB(1, 0), cB + kstep, voffB); PG8_STAGE(PG8_SA(1, 0), cA + kstep, voffA); PG8_STAGE(PG8_SB(1, 1), cB + hstep + kstep, voffB);
        PG8_WAIT_V(6); PG8_BAR;
    }
    for (;;) {
        const bool has_next = S.next(ui + 1, nxt);
        const char* nA = has_next ? (const char*)g.A + (size_t)nxt.pm * tstep : cA; const char* nB = has_next ? (const char*)g.Bt + (size_t)nxt.pn * tstep : cB;
        for (int t = 0; t < nt; t += 2) {
            const bool last = (t == nt - 2);
            const char* a1 = cA + (size_t)(t + 1) * kstep;
            const char* a2 = last ? nA : cA + (size_t)(t + 2) * kstep; const char* b2 = last ? nB : cB + (size_t)(t + 2) * kstep;
            const char* a3 = a2 + kstep; const char* b3 = b2 + kstep;
            if (last && has_next) S.a_ready(nxt);
            if constexpr (SP2) {
            PG8_LDB(B0, 0, 0); PG8_LDB(B1, 0, 1); PG8_SCHED; PG8_LDA(At, 0, 0); PG8_STAGE(PG8_SA(1, 1), a1 + hstep, voffA);
            PG8_WAIT_V(8); PG8_WAIT_L(0); PG8_BAR; PG8_MMA(0, 0, At, B0); PG8_MMA(0, 1, At, B1); PG8_BAR; PG8_SCHED;
            PG8_LDA(At, 0, 1); PG8_STAGE(PG8_SB(0, 0), b2, voffB); PG8_STAGE(PG8_SB(0, 1), b2 + hstep, voffB); PG8_STAGE(PG8_SA(0, 0), a2, voffA);
            PG8_WAIT_V(8); PG8_WAIT_L(0); PG8_BAR; PG8_MMA(1, 0, At, B0); PG8_MMA(1, 1, At, B1); PG8_BAR; PG8_SCHED;
            PG8_LDB(B0, 1, 0); PG8_LDB(B1, 1, 1); PG8_SCHED; PG8_LDA(At, 1, 0); PG8_STAGE(PG8_SA(0, 1), a2 + hstep, voffA);
            PG8_WAIT_V(8); PG8_WAIT_L(0); PG8_BAR; PG8_MMA(0, 0, At, B0); PG8_MMA(0, 1, At, B1); PG8_BAR; PG8_SCHED;
            PG8_LDA(At, 1, 1); PG8_STAGE(PG8_SB(1, 0), b3, voffB); PG8_STAGE(PG8_SB(1, 1), b3 + hstep, voffB); PG8_STAGE(PG8_SA(1, 0), a3, voffA);
            PG8_WAIT_V(8); PG8_WAIT_L(0); PG8_BAR; PG8_MMA(1, 0, At, B0); PG8_MMA(1, 1, At, B1); PG8_BAR; PG8_SCHED;
            } else {
            PG8_LDB(B0, 0, 0); PG8_SCHED; PG8_LDA(At, 0, 0); PG8_STAGE(PG8_SA(1, 1), a1 + hstep, voffA);
            PG8_WAIT_L(8); PG8_BAR; PG8_WAIT_L(0); PG8_MMA(0, 0, At, B0); PG8_BAR; PG8_SCHED;
            PG8_LDB(B1, 0, 1); PG8_STAGE(PG8_SB(0, 0), b2, voffB);
            PG8_BAR; PG8_WAIT_L(0); PG8_MMA(0, 1, At, B1); PG8_BAR;
            PG8_LDA(At, 0, 1); PG8_STAGE(PG8_SA(0, 0), a2, voffA);
            PG8_BAR; PG8_WAIT_L(0); PG8_MMA(1, 0, At, B0); PG8_BAR; PG8_SCHED;
            PG8_STAGE(PG8_SB(0, 1), b2 + hstep, voffB);
            PG8_WAIT_V(6); PG8_BAR; PG8_MMA(1, 1, At, B1); PG8_BAR;
            PG8_LDB(B0, 1, 0); PG8_SCHED; PG8_LDA(At, 1, 0); PG8_STAGE(PG8_SA(0, 1), a2 + hstep, voffA);
            PG8_WAIT_L(8); PG8_BAR; PG8_WAIT_L(0); PG8_MMA(0, 0, At, B0); PG8_BAR; PG8_SCHED;
            PG8_LDB(B1, 1, 1); PG8_STAGE(PG8_SB(1, 0), b3, voffB);
            PG8_BAR; PG8_WAIT_L(0); PG8_MMA(0, 1, At, B1); PG8_BAR;
            PG8_LDA(At, 1, 1); PG8_STAGE(PG8_SA(1, 0), a3, voffA);
            PG8_BAR; PG8_WAIT_L(0); PG8_MMA(1, 0, At, B0); PG8_BAR; PG8_SCHED;
            PG8_STAGE(PG8_SB(1, 1), b3 + hstep, voffB);
            PG8_WAIT_V(6); PG8_BAR; PG8_MMA(1, 1, At, B1); PG8_BAR;
            }
        }
        if constexpr (ALIGN_EPI) { if (wr == 0) PG8_BAR; }
        if constexpr (!Epi::AFTER_DRAIN) { E(acc, cur, wr, wc, fr, fq); S.done(cur); }
        if (!has_next) break;
#pragma unroll
        for (int a = 0; a < 2; ++a)
#pragma unroll
            for (int b = 0; b < 2; ++b)
#pragma unroll
                for (int m = 0; m < 4; ++m)
#pragma unroll
                    for (int n = 0; n < 2; ++n) acc[a][b][m][n] = (f32x4){0.f, 0.f, 0.f, 0.f};
        cur = nxt; cA = nA; cB = nB; ++ui;
        if constexpr (ALIGN_EPI) { if (wr == 1) PG8_BAR; }
    }
    PG8_WAIT_V(0);
    if constexpr (!ALIGN_EPI) { if (wr == 0) PG8_BAR; }
    PG8_BAR;
    if constexpr (Epi::AFTER_DRAIN) { E.fused(acc, cur, wr, wc, fr, fq, lds, wid, lane); S.done(cur); }
#undef PG8_SA
#undef PG8_SB
#undef PG8_STAGE
#undef PG8_LDA
#undef PG8_LDB
#undef PG8_MMA
#undef PG8_WAIT_V
#undef PG8_WAIT_L
#undef PG8_BAR
#undef PG8_SCHED
}
}

namespace att {
typedef unsigned short bf16_t;
using bf16x8 = __attribute__((ext_vector_type(8))) short;
using s16x4  = __attribute__((ext_vector_type(4))) short;
using f32x16 = __attribute__((ext_vector_type(16))) float;
using f32x4  = __attribute__((ext_vector_type(4))) float;
using u32x4  = __attribute__((ext_vector_type(4))) unsigned;
constexpr int NW = 8, QBLK = 32, KVBLK = 64;
constexpr float THR = 8.f;
constexpr int SHM_V = KVBLK * 128 * 2, SHM_K = KVBLK * 128 * 2, SHM_KR = KVBLK * 64 * 2;
constexpr int OFF_V = 0, OFF_K = 2 * SHM_V, OFF_KR = OFF_K + 2 * SHM_K, OFF_WS = OFF_KR + 2 * SHM_KR, OFF_QR = OFF_WS + NW * 64 * 4, ATT_LDS = OFF_QR + NW * 4096;
#define KSWZ(row, colB) ((row) * 256 + ((colB) ^ (((row) & 15) << 4)))
#define KRSWZ(row, colB) ((row) * 128 + ((colB) ^ ((((row) >> 1) & 7) << 4)))
#define SBAR() __builtin_amdgcn_sched_barrier(0)
__device__ __forceinline__ int crow(int r, int hi) { return (r & 3) + 8 * (r >> 2) + 4 * hi; }
__device__ __forceinline__ unsigned cvtpk(float lo, float hi) { unsigned r; asm volatile("v_cvt_pk_bf16_f32 %0, %1, %2" : "=v"(r) : "v"(lo), "v"(hi)); return r; }
__device__ __forceinline__ float bf2f(short s) { return __uint_as_float(((unsigned)(unsigned short)s) << 16); }

template <int DQK> struct SC { static constexpr float SCALE = DQK == 192 ? 0.07216878364870322f : 0.08838834764831845f; };

template <int DQK>
__device__ __forceinline__ void partialSM(f32x16& p0, f32x16& p1, float& m_reg, float& mn, float& alpha) {
  constexpr float SCALE = SC<DQK>::SCALE; constexpr float C = SCALE * 1.4426950408889634f;
  float pmax = p0[0]; for (int r = 1; r < 16; ++r) pmax = fmaxf(pmax, p0[r]); for (int r = 0; r < 16; ++r) pmax = fmaxf(pmax, p1[r]);
  { auto rr = __builtin_amdgcn_permlane32_swap(__float_as_uint(pmax), __float_as_uint(pmax), false, false);
    pmax = fmaxf(__uint_as_float(rr[0]), __uint_as_float(rr[1])); }
  if (__builtin_expect(__all(pmax - m_reg <= THR / SCALE), 1)) { mn = m_reg; alpha = 1.f; }
  else { mn = fmaxf(m_reg, pmax); alpha = __builtin_amdgcn_exp2f((m_reg - mn) * C); m_reg = mn; }
  float mnC = -mn * C;
  for (int r = 0; r < 16; ++r) p0[r] = fmaf(p0[r], C, mnC); for (int r = 0; r < 16; ++r) p1[r] = fmaf(p1[r], C, mnC);
  for (int r = 0; r < 16; ++r) p0[r] = __builtin_amdgcn_exp2f(p0[r]);
}
__device__ __forceinline__ void finishSM(f32x16& p0, f32x16& p1, float alpha, float& l_reg, bf16x8& pa0, bf16x8& pa1, bf16x8& pa2, bf16x8& pa3) {
  for (int r = 0; r < 16; ++r) p1[r] = __builtin_amdgcn_exp2f(p1[r]);
  float ps = 0; for (int r = 0; r < 16; ++r) ps += p0[r]; for (int r = 0; r < 16; ++r) ps += p1[r];
  { auto rr = __builtin_amdgcn_permlane32_swap(__float_as_uint(ps), __float_as_uint(ps), false, false);
    ps = __uint_as_float(rr[0]) + __uint_as_float(rr[1]); }
  l_reg = l_reg * alpha + ps;
#define PK4(P, BASE, OUT) do { unsigned a0 = cvtpk(P[BASE + 0], P[BASE + 1]), a1 = cvtpk(P[BASE + 2], P[BASE + 3]);   \
    unsigned b0 = cvtpk(P[BASE + 4], P[BASE + 5]), b1 = cvtpk(P[BASE + 6], P[BASE + 7]);                              \
    auto r0 = __builtin_amdgcn_permlane32_swap(a0, b0, false, false); auto r1 = __builtin_amdgcn_permlane32_swap(a1, b1, false, false); \
    u32x4 w = {r0[0], r1[0], r0[1], r1[1]}; OUT = *reinterpret_cast<bf16x8*>(&w); } while (0)
  PK4(p0, 0, pa0); PK4(p0, 8, pa1); PK4(p1, 0, pa2); PK4(p1, 8, pa3);
#undef PK4
}
template <int DQK>
__device__ __forceinline__ void qkt(f32x16& p0, f32x16& p1, const char* Ks, const char* KRs, const bf16x8* qr, const char* qrl, int r32, int hi) {
  p0 = f32x16{}; p1 = f32x16{};
#pragma unroll
  for (int d0 = 0; d0 < 8; ++d0) { int cb = (d0 * 16 + hi * 8) * 2;
    bf16x8 b0 = *reinterpret_cast<const bf16x8*>(Ks + KSWZ(r32, cb));
    bf16x8 b1 = *reinterpret_cast<const bf16x8*>(Ks + KSWZ(32 + r32, cb));
    p0 = __builtin_amdgcn_mfma_f32_32x32x16_bf16(b0, qr[d0], p0, 0, 0, 0);
    p1 = __builtin_amdgcn_mfma_f32_32x32x16_bf16(b1, qr[d0], p1, 0, 0, 0); }
  if constexpr (DQK == 192) {
#pragma unroll
    for (int d0 = 0; d0 < 4; ++d0) { int cb = (d0 * 16 + hi * 8) * 2;
      bf16x8 b0 = *reinterpret_cast<const bf16x8*>(KRs + KRSWZ(r32, cb));
      bf16x8 b1 = *reinterpret_cast<const bf16x8*>(KRs + KRSWZ(32 + r32, cb));
      const bf16x8 qx = *reinterpret_cast<const bf16x8*>(qrl + d0 * 1024);
      p0 = __builtin_amdgcn_mfma_f32_32x32x16_bf16(b0, qx, p0, 0, 0, 0);
      p1 = __builtin_amdgcn_mfma_f32_32x32x16_bf16(b1, qx, p1, 0, 0, 0); }
  }
}
__device__ __forceinline__ int v_st(int k, int c) { const int kk = (k & ~0xC) | ((k & 4) << 1) | ((k & 8) >> 1); return ((kk >> 3) * 4 + (c >> 5)) * 512 + ((kk & 7) * 32 + (c & 31)) * 2; }
__device__ __forceinline__ int v_rd_base(int lane) { return ((lane & 3) << 3) | (((lane >> 2) & 3) << 6) | (((lane >> 4) & 1) << 5) | (((lane >> 5) & 1) << 8); }
constexpr int v_rd_off(int d0, int ks, int half) { return d0 * 512 + ks * 4096 + half * 2048; }
template <int OFF> __device__ __forceinline__ s16x4 tr_read(int vb) {
  s16x4 r; asm volatile("ds_read_b64_tr_b16 %0, %1 offset:%2" : "=&v"(r) : "v"(vb), "i"(OFF) : "memory"); return r;
}
template <int D0> __device__ __forceinline__ void pv_one(f32x16& od, int vb, bf16x8 pa0, bf16x8 pa1, bf16x8 pa2, bf16x8 pa3) {
  const s16x4 l0 = tr_read<v_rd_off(D0, 0, 0)>(vb), h0 = tr_read<v_rd_off(D0, 0, 1)>(vb), l1 = tr_read<v_rd_off(D0, 1, 0)>(vb), h1 = tr_read<v_rd_off(D0, 1, 1)>(vb);
  const s16x4 l2 = tr_read<v_rd_off(D0, 2, 0)>(vb), h2 = tr_read<v_rd_off(D0, 2, 1)>(vb), l3 = tr_read<v_rd_off(D0, 3, 0)>(vb), h3 = tr_read<v_rd_off(D0, 3, 1)>(vb);
  asm volatile("s_waitcnt lgkmcnt(0)" ::: "memory"); SBAR();
#define PK(L, H) (bf16x8){L[0], L[1], L[2], L[3], H[0], H[1], H[2], H[3]}
  od = __builtin_amdgcn_mfma_f32_32x32x16_bf16(pa0, PK(l0, h0), od, 0, 0, 0);
  od = __builtin_amdgcn_mfma_f32_32x32x16_bf16(pa1, PK(l1, h1), od, 0, 0, 0);
  od = __builtin_amdgcn_mfma_f32_32x32x16_bf16(pa2, PK(l2, h2), od, 0, 0, 0);
  od = __builtin_amdgcn_mfma_f32_32x32x16_bf16(pa3, PK(l3, h3), od, 0, 0, 0);
#undef PK
}
__device__ __forceinline__ void pv_d0(f32x16* o, int vb, bf16x8 pa0, bf16x8 pa1, bf16x8 pa2, bf16x8 pa3) {
  pv_one<0>(o[0], vb, pa0, pa1, pa2, pa3); pv_one<1>(o[1], vb, pa0, pa1, pa2, pa3); pv_one<2>(o[2], vb, pa0, pa1, pa2, pa3); pv_one<3>(o[3], vb, pa0, pa1, pa2, pa3);
}

template <int DQK, int SDEPTH, int ldq, int ldk, int ldv, int ldo>
__device__ __forceinline__ void attn_body(const bf16_t* __restrict__ Qb, const bf16_t* __restrict__ Kh, const bf16_t* __restrict__ KRh,
                                          const bf16_t* __restrict__ Vh, bf16_t* __restrict__ Ob, int seq,
                                          const float* __restrict__ cs, const float* __restrict__ sn, char* lds) {
  constexpr bool ROPE = DQK == 192; constexpr int ND0 = DQK / 16;
  const int tid = fresh_tid(), wid = tid >> 6, lane = tid & 63, r32 = lane & 31, hi = lane >> 5;
  char* V_lds = lds + OFF_V; char* K_lds = lds + OFF_K; char* KR_lds = lds + OFF_KR;
  float* ws = (float*)(lds + OFF_WS) + wid * 64; float* li_l = ws; float* al_l = ws + 32;
  float m_reg = -1e30f, l_reg = 0; f32x16 o[4] = {}; bf16x8 qr[8];
  char* qrl = lds + OFF_QR + wid * 4096 + lane * 16;
  __syncthreads();
  const bf16_t* Qw = Qb + (size_t)(wid * QBLK + r32) * ldq + hi * 8;
#pragma unroll
  for (int d0 = 0; d0 < 8; ++d0) qr[d0] = *reinterpret_cast<const bf16x8*>(Qw + d0 * 16);
  if constexpr (ROPE) {
    bf16x8 qx[4];
#pragma unroll
    for (int d0 = 0; d0 < 4; ++d0) qx[d0] = *reinterpret_cast<const bf16x8*>(Qw + 128 + d0 * 16);
    if (cs) {
      const float* cr = cs + (size_t)(wid * QBLK + r32) * 32 + hi * 8; const float* sr2 = sn + (size_t)(wid * QBLK + r32) * 32 + hi * 8;
#pragma unroll
      for (int p = 0; p < 2; ++p) {
        const f32x4 c0 = *(const f32x4*)(cr + p * 16), c1 = *(const f32x4*)(cr + p * 16 + 4), s0 = *(const f32x4*)(sr2 + p * 16), s1 = *(const f32x4*)(sr2 + p * 16 + 4);
        float x1[8], x2[8], y1[8], y2[8];
#pragma unroll
        for (int e = 0; e < 8; ++e) { x1[e] = bf2f(qx[p][e]); x2[e] = bf2f(qx[2 + p][e]); }
#pragma unroll
        for (int e = 0; e < 8; ++e) { const float c = e < 4 ? c0[e & 3] : c1[e & 3], s = e < 4 ? s0[e & 3] : s1[e & 3]; y1[e] = x1[e] * c - x2[e] * s; y2[e] = x1[e] * s + x2[e] * c; }
        u32x4 w1 = {cvtpk(y1[0], y1[1]), cvtpk(y1[2], y1[3]), cvtpk(y1[4], y1[5]), cvtpk(y1[6], y1[7])};
        u32x4 w2 = {cvtpk(y2[0], y2[1]), cvtpk(y2[2], y2[3]), cvtpk(y2[4], y2[5]), cvtpk(y2[6], y2[7])};
        qx[p] = *reinterpret_cast<bf16x8*>(&w1); qx[2 + p] = *reinterpret_cast<bf16x8*>(&w2);
      }
    }
#pragma unroll
    for (int d0 = 0; d0 < 4; ++d0) *reinterpret_cast<bf16x8*>(qrl + d0 * 1024) = qx[d0];
  }
  const int sr = tid >> 4, sc = (tid & 15) * 8, vst0 = v_st(sr, sc), vst1 = v_st(32 + sr, sc);
  const int krr = tid >> 3, krc = (tid & 7) * 8;
  const int vb0 = (int)(uintptr_t)V_lds + v_rd_base(lane);
  struct { bf16x8 vs0, vs1, ks0, ks1, kr; } sr_[SDEPTH];
#define SLOAD(i, k0) do { sr_[i].vs0 = *(const bf16x8*)(&Vh[(size_t)((k0) + sr) * ldv + sc]); sr_[i].vs1 = *(const bf16x8*)(&Vh[(size_t)((k0) + 32 + sr) * ldv + sc]); \
    sr_[i].ks0 = *(const bf16x8*)(&Kh[(size_t)((k0) + sr) * ldk + sc]); sr_[i].ks1 = *(const bf16x8*)(&Kh[(size_t)((k0) + 32 + sr) * ldk + sc]); \
    if constexpr (ROPE) sr_[i].kr = *(const bf16x8*)(&KRh[(size_t)((k0) + krr) * 64 + krc]); } while (0)
#define SWRITE(b, i) do { *(bf16x8*)(V_lds + (b) * SHM_V + vst0) = sr_[i].vs0;          \
    *(bf16x8*)(V_lds + (b) * SHM_V + vst1) = sr_[i].vs1; int kc = sc * 2;               \
    *(bf16x8*)(K_lds + (b) * SHM_K + KSWZ(sr, kc)) = sr_[i].ks0;                       \
    *(bf16x8*)(K_lds + (b) * SHM_K + KSWZ(32 + sr, kc)) = sr_[i].ks1;                  \
    if constexpr (ROPE) *(bf16x8*)(KR_lds + (b) * SHM_KR + KRSWZ(krr, krc * 2)) = sr_[i].kr; } while (0)
#define SWAIT() do { if constexpr (SDEPTH == 2) { if constexpr (ROPE) asm volatile("s_waitcnt vmcnt(5)" ::: "memory"); else asm volatile("s_waitcnt vmcnt(4)" ::: "memory"); } \
    else asm volatile("s_waitcnt vmcnt(0)" ::: "memory"); } while (0)
#define RESC(a) do { if (__any((a) < 1.f)) { if (hi == 0) al_l[r32] = (a); asm volatile("s_waitcnt lgkmcnt(0)" ::: "memory"); \
    for (int d = 0; d < 4; ++d) for (int r = 0; r < 16; ++r) o[d][r] *= al_l[crow(r, hi)]; } } while (0)
  f32x16 pA0, pA1, pB0, pB1; float mnA, mnB, alA, alB; bf16x8 pa0, pa1, pa2, pa3; const int NT = seq / KVBLK;
  constexpr int SE = 0, SO = SDEPTH - 1;
  SLOAD(SE, 0); asm volatile("s_waitcnt vmcnt(0)" ::: "memory"); SWRITE(0, SE); __syncthreads();
  qkt<DQK>(pA0, pA1, K_lds, KR_lds, qr, qrl, r32, hi); partialSM<DQK>(pA0, pA1, m_reg, mnA, alA);
  SLOAD(SO, KVBLK); if constexpr (SDEPTH == 2) { if (2 < NT) SLOAD(SE, 2 * KVBLK); }
  SWAIT(); SWRITE(1, SO); __syncthreads();
  for (int j = 1; j + 1 < NT; j += 2) {
    SBAR(); qkt<DQK>(pB0, pB1, K_lds + SHM_K, KR_lds + SHM_KR, qr, qrl, r32, hi);
    finishSM(pA0, pA1, alA, l_reg, pa0, pa1, pa2, pa3); SBAR();
    SLOAD(SO, (j + SDEPTH) * KVBLK); SBAR();
    pv_d0(o, vb0, pa0, pa1, pa2, pa3); partialSM<DQK>(pB0, pB1, m_reg, mnB, alB);
    __syncthreads(); SWAIT(); SWRITE(0, SE);
    RESC(alB); __syncthreads();
    SBAR(); qkt<DQK>(pA0, pA1, K_lds, KR_lds, qr, qrl, r32, hi);
    finishSM(pB0, pB1, alB, l_reg, pa0, pa1, pa2, pa3); SBAR();
    if (SDEPTH == 1 || j + 3 < NT) SLOAD(SE, (j + 1 + SDEPTH) * KVBLK); SBAR();
    pv_d0(o, vb0 + (int)SHM_V, pa0, pa1, pa2, pa3); partialSM<DQK>(pA0, pA1, m_reg, mnA, alA);
    __syncthreads(); SWAIT(); SWRITE(1, SO);
    RESC(alA); __syncthreads();
  }
  SBAR(); qkt<DQK>(pB0, pB1, K_lds + SHM_K, KR_lds + SHM_KR, qr, qrl, r32, hi);
  finishSM(pA0, pA1, alA, l_reg, pa0, pa1, pa2, pa3); SBAR();
  pv_d0(o, vb0, pa0, pa1, pa2, pa3); partialSM<DQK>(pB0, pB1, m_reg, mnB, alB);
  __syncthreads(); RESC(alB);
  finishSM(pB0, pB1, alB, l_reg, pa0, pa1, pa2, pa3); SBAR();
  pv_d0(o, vb0 + (int)SHM_V, pa0, pa1, pa2, pa3);
  if (hi == 0) li_l[r32] = l_reg; asm volatile("s_waitcnt lgkmcnt(0)" ::: "memory");
  __syncthreads();
  char* Wl = lds + wid * 8192 + hi * 1024 + r32 * 2;
#pragma unroll
  for (int r = 0; r < 16; r += 2) {
    const float ra = __builtin_amdgcn_rcpf(li_l[crow(r, hi)]), rb = __builtin_amdgcn_rcpf(li_l[crow(r + 1, hi)]);
#pragma unroll
    for (int d0 = 0; d0 < 4; ++d0) {
      const unsigned w = cvtpk(o[d0][r] * ra, o[d0][r + 1] * rb);
      *(unsigned short*)(Wl + crow(r, 0) * 256 + d0 * 64) = (unsigned short)(w & 0xffffu);
      *(unsigned short*)(Wl + crow(r + 1, 0) * 256 + d0 * 64) = (unsigned short)(w >> 16);
    }
    SBAR();
  }
  asm volatile("s_waitcnt lgkmcnt(0)" ::: "memory");
  bf16_t* Ow = Ob + (size_t)(wid * QBLK) * ldo;
#pragma unroll
  for (int i = 0; i < 8; ++i) { const int ch = i * 64 + lane, row = ch >> 4, c16 = ch & 15;
    const u32x4 v = *(const u32x4*)(lds + wid * 8192 + row * 256 + c16 * 16);
    *(u32x4*)(Ow + (size_t)row * ldo + c16 * 8) = v; }
#undef SLOAD
#undef SWRITE
#undef SWAIT
#undef RESC
}

struct VFrag { s16x4 l0, h0, l1, h1, l2, h2, l3, h3; };
template <int KS> __device__ __forceinline__ VFrag v_frag(int vb) {
  VFrag f; f.l0 = tr_read<v_rd_off(0, KS, 0)>(vb); f.h0 = tr_read<v_rd_off(0, KS, 1)>(vb); f.l1 = tr_read<v_rd_off(1, KS, 0)>(vb); f.h1 = tr_read<v_rd_off(1, KS, 1)>(vb);
  f.l2 = tr_read<v_rd_off(2, KS, 0)>(vb); f.h2 = tr_read<v_rd_off(2, KS, 1)>(vb); f.l3 = tr_read<v_rd_off(3, KS, 0)>(vb); f.h3 = tr_read<v_rd_off(3, KS, 1)>(vb); return f;
}
#define PKV(L, H) (bf16x8){L[0], L[1], L[2], L[3], H[0], H[1], H[2], H[3]}
__device__ __forceinline__ void pv_step(f32x16* o, bf16x8 pa, const VFrag& f) {
  o[0] = __builtin_amdgcn_mfma_f32_32x32x16_bf16(pa, PKV(f.l0, f.h0), o[0], 0, 0, 0);
  o[1] = __builtin_amdgcn_mfma_f32_32x32x16_bf16(pa, PKV(f.l1, f.h1), o[1], 0, 0, 0);
  o[2] = __builtin_amdgcn_mfma_f32_32x32x16_bf16(pa, PKV(f.l2, f.h2), o[2], 0, 0, 0);
  o[3] = __builtin_amdgcn_mfma_f32_32x32x16_bf16(pa, PKV(f.l3, f.h3), o[3], 0, 0, 0);
}
__device__ __forceinline__ void pv_d0_pf(f32x16* o, int vb, bf16x8 pa0, bf16x8 pa1, bf16x8 pa2, bf16x8 pa3) {
  VFrag a = v_frag<0>(vb); VFrag b = v_frag<1>(vb);
  asm volatile("s_waitcnt lgkmcnt(8)" ::: "memory"); SBAR(); pv_step(o, pa0, a); SBAR();
  a = v_frag<2>(vb);
  asm volatile("s_waitcnt lgkmcnt(8)" ::: "memory"); SBAR(); pv_step(o, pa1, b); SBAR();
  b = v_frag<3>(vb);
  asm volatile("s_waitcnt lgkmcnt(8)" ::: "memory"); SBAR(); pv_step(o, pa2, a); SBAR();
  asm volatile("s_waitcnt lgkmcnt(0)" ::: "memory"); SBAR(); pv_step(o, pa3, b); SBAR();
}
#undef PKV

constexpr int PX_V = 0, PX_K = 65536, PX_X1 = PX_K + 3 * 16384, PX_PS = PX_X1 + 2048, PX_X2 = PX_PS + 1024, PX_WS = PX_X2 + 16384, PX_END = PX_WS + 2048;
static_assert(PX_END <= 147456 - 16, "pair-exchange LDS map");
__device__ __forceinline__ void px_pass(const bf16_t* __restrict__ Qb, const bf16_t* __restrict__ Kh, const bf16_t* __restrict__ Vh, int seq, char* lds, f32x16 (&o)[4], float& l_out) {
  constexpr int LD = 6144; constexpr float SCALE = 0.08838834764831845f, C = SCALE * 1.4426950408889634f;
  const int tid = fresh_tid(), wid = tid >> 6, lane = tid & 63, r32 = lane & 31, hi = lane >> 5, grp = wid & 3, role = wid >> 2, pw = wid ^ 4;
  float* X1 = (float*)(lds + PX_X1); float* PS = (float*)(lds + PX_PS); char* X2 = lds + PX_X2;
  float* al_l = (float*)(lds + PX_WS) + wid * 64;
  float l_reg = 0.f;
  float m_reg = -1e30f; bf16x8 qr[8];
#pragma unroll
  for (int d = 0; d < 4; ++d) o[d] = f32x16{};
  __syncthreads();
  const bf16_t* Qw = Qb + (size_t)(grp * 32 + r32) * LD + hi * 8;
#pragma unroll
  for (int d0 = 0; d0 < 8; ++d0) qr[d0] = *reinterpret_cast<const bf16x8*>(Qw + d0 * 16);
  const int sr = tid >> 4, sc = (tid & 15) * 8, vr = tid >> 3, vc = tid & 7;
  bf16x8 ks0, ks1, vv[4];
#define PX_KLOAD(k0) do { ks0 = *(const bf16x8*)(&Kh[(size_t)((k0) + sr) * LD + sc]); ks1 = *(const bf16x8*)(&Kh[(size_t)((k0) + 32 + sr) * LD + sc]); } while (0)
#define PX_VLOAD(k0) do { _Pragma("unroll") for (int i = 0; i < 4; ++i) vv[i] = *(const bf16x8*)(&Vh[(size_t)((k0) + vr) * LD + (vc + 8 * i) * 8]); } while (0)
#define PX_KWRITE(slot) do { *(bf16x8*)(lds + PX_K + (slot) * 16384 + KSWZ(sr, sc * 2)) = ks0; *(bf16x8*)(lds + PX_K + (slot) * 16384 + KSWZ(32 + sr, sc * 2)) = ks1; } while (0)
#define PX_VWRITE(slot) do { _Pragma("unroll") for (int i = 0; i < 4; ++i) { const int col = (vc + 8 * i) * 8; *(bf16x8*)(lds + PX_V + (slot) * 32768 + (col >> 7) * 16384 + v_st(vr, col & 127)) = vv[i]; } } while (0)
#define PX_QK(P, PMAX, slot) do { const char* Ks_ = lds + PX_K + (slot) * 16384; P = f32x16{}; \
    _Pragma("unroll") for (int d0 = 0; d0 < 8; ++d0) { const bf16x8 kb = *reinterpret_cast<const bf16x8*>(Ks_ + KSWZ(role * 32 + r32, (d0 * 16 + hi * 8) * 2)); \
      P = __builtin_amdgcn_mfma_f32_32x32x16_bf16(kb, qr[d0], P, 0, 0, 0); } \
    PMAX = P[0]; _Pragma("unroll") for (int r = 1; r < 16; ++r) PMAX = fmaxf(PMAX, P[r]); \
    { auto rr = __builtin_amdgcn_permlane32_swap(__float_as_uint(PMAX), __float_as_uint(PMAX), false, false); PMAX = fmaxf(__uint_as_float(rr[0]), __uint_as_float(rr[1])); } } while (0)
  const int NT = seq / KVBLK;
  const int vbase = (int)(uintptr_t)(lds + PX_V) + role * 16384 + v_rd_base(lane);
  f32x16 pn; float pmaxn;
  PX_KLOAD(0); PX_VLOAD(0); PX_KWRITE(0); PX_VWRITE(0); if (1 < NT) PX_KLOAD(KVBLK);
  __syncthreads();
  PX_QK(pn, pmaxn, 0); if (hi == 0) X1[wid * 32 + r32] = pmaxn;
  if (1 < NT) { PX_KWRITE(1); PX_VLOAD(KVBLK); } if (2 < NT) PX_KLOAD(2 * KVBLK);
  __syncthreads();
  int kslot = 1;
  for (int t = 0; t < NT; ++t) {
    f32x16 p = pn; float pmax = fmaxf(pmaxn, X1[(t & 1) * 256 + pw * 32 + r32]);
    if (t + 1 < NT) { PX_QK(pn, pmaxn, kslot); if (hi == 0) X1[((t + 1) & 1) * 256 + wid * 32 + r32] = pmaxn; }
    float mn, alpha;
    if (__builtin_expect(__all(pmax - m_reg <= THR / SCALE), 1)) { mn = m_reg; alpha = 1.f; }
    else { mn = fmaxf(m_reg, pmax); alpha = __builtin_amdgcn_exp2f((m_reg - mn) * C); m_reg = mn; }
    const float mnC = -mn * C; float ps = 0.f;
#pragma unroll
    for (int r = 0; r < 16; ++r) { p[r] = __builtin_amdgcn_exp2f(fmaf(p[r], C, mnC)); ps += p[r]; }
    { auto rr = __builtin_amdgcn_permlane32_swap(__float_as_uint(ps), __float_as_uint(ps), false, false); ps = __uint_as_float(rr[0]) + __uint_as_float(rr[1]); }
    bf16x8 fa, fb;
#define PK4(P, BASE, OUT) do { unsigned a0 = cvtpk(P[BASE + 0], P[BASE + 1]), a1 = cvtpk(P[BASE + 2], P[BASE + 3]);   \
    unsigned b0 = cvtpk(P[BASE + 4], P[BASE + 5]), b1 = cvtpk(P[BASE + 6], P[BASE + 7]);                              \
    auto r0 = __builtin_amdgcn_permlane32_swap(a0, b0, false, false); auto r1 = __builtin_amdgcn_permlane32_swap(a1, b1, false, false); \
    u32x4 w = {r0[0], r1[0], r0[1], r1[1]}; OUT = *reinterpret_cast<bf16x8*>(&w); } while (0)
    PK4(p, 0, fa); PK4(p, 8, fb);
#undef PK4
    *(bf16x8*)(X2 + (wid * 64 + lane) * 32) = fa; *(bf16x8*)(X2 + (wid * 64 + lane) * 32 + 16) = fb;
    if (hi == 0) PS[wid * 32 + r32] = ps;
    if (__any(alpha < 1.f)) { if (hi == 0) al_l[r32] = alpha; asm volatile("s_waitcnt lgkmcnt(0)" ::: "memory");
#pragma unroll
      for (int d = 0; d < 4; ++d)
#pragma unroll
        for (int r = 0; r < 16; ++r) o[d][r] *= al_l[crow(r, hi)]; }
    if (t + 1 < NT) { PX_VWRITE((t + 1) & 1); if (t + 2 < NT) PX_VLOAD((t + 2) * KVBLK); }
    __syncthreads();
    const bf16x8 ga = *(const bf16x8*)(X2 + (pw * 64 + lane) * 32), gb = *(const bf16x8*)(X2 + (pw * 64 + lane) * 32 + 16);
    const float psp = PS[pw * 32 + r32];
    l_reg = l_reg * alpha + (role == 0 ? ps + psp : psp + ps);
    const bf16x8 pa0 = role == 0 ? fa : ga, pa1 = role == 0 ? fb : gb, pa2 = role == 0 ? ga : fa, pa3 = role == 0 ? gb : fb;
    asm volatile("s_waitcnt lgkmcnt(0)" ::: "memory"); SBAR();
    pv_d0_pf(o, vbase + (t & 1) * 32768, pa0, pa1, pa2, pa3);
    kslot = kslot == 2 ? 0 : kslot + 1;
    if (t + 2 < NT) { PX_KWRITE(kslot); if (t + 3 < NT) PX_KLOAD((t + 3) * KVBLK); }
    __syncthreads();
  }
  l_out = l_reg;
#undef PX_KLOAD
#undef PX_VLOAD
#undef PX_KWRITE
#undef PX_VWRITE
#undef PX_QK
}
__device__ __forceinline__ void attn_px_body(const bf16_t* __restrict__ Qb0, const bf16_t* __restrict__ Kh0, const bf16_t* __restrict__ Vh, bf16_t* __restrict__ Ob, int seq, float lam_u, const float* __restrict__ sg, unsigned* __restrict__ park, char* lds) {
  constexpr int LDO = 2048;
  f32x16 o[4]; float l_reg = 0.f;
  px_pass(Qb0, Kh0, Vh, seq, lds, o, l_reg);
  {
    const int tid = fresh_tid(), wid = tid >> 6, lane = tid & 63, r32 = lane & 31, hi = lane >> 5;
    float* li_l = (float*)(lds + PX_WS) + wid * 64 + 32; unsigned* pk = park + wid * 64 + lane;
    if (hi == 0) li_l[r32] = l_reg; asm volatile("s_waitcnt lgkmcnt(0)" ::: "memory");
#pragma unroll
    for (int r = 0; r < 16; r += 2) { const float ra = __builtin_amdgcn_rcpf(li_l[crow(r, hi)]), rb = __builtin_amdgcn_rcpf(li_l[crow(r + 1, hi)]);
#pragma unroll
      for (int d = 0; d < 4; ++d) pk[(d * 8 + (r >> 1)) * 512] = cvtpk(o[d][r] * ra, o[d][r + 1] * rb); }
  }
  px_pass(Qb0 + 128, Kh0 + 128, Vh, seq, lds, o, l_reg);
  const int tid = fresh_tid(), wid = tid >> 6, lane = tid & 63, r32 = lane & 31, hi = lane >> 5, grp = wid & 3, role = wid >> 2, pw = wid ^ 4;
  float* li_l = (float*)(lds + PX_WS) + wid * 64 + 32; unsigned* pk = park + wid * 64 + lane;
  const float lam = __uint_as_float(__builtin_amdgcn_readfirstlane(__float_as_uint(lam_u)));
  if (hi == 0) li_l[r32] = l_reg; asm volatile("s_waitcnt lgkmcnt(0)" ::: "memory");
  float gsc[4];
#pragma unroll
  for (int d = 0; d < 4; ++d) gsc[d] = sg[role * 128 + d * 32 + r32] * 0.8f;
  float sq[16];
#pragma unroll
  for (int r = 0; r < 16; r += 2) { const float ra = __builtin_amdgcn_rcpf(li_l[crow(r, hi)]), rb = __builtin_amdgcn_rcpf(li_l[crow(r + 1, hi)]); float sa = 0.f, sb = 0.f;
#pragma unroll
    for (int d = 0; d < 4; ++d) { const unsigned q1 = __hip_atomic_load(pk + (d * 8 + (r >> 1)) * 512, __ATOMIC_RELAXED, __HIP_MEMORY_SCOPE_AGENT);     const float a = __uint_as_float(q1 << 16) - lam * (o[d][r] * ra), bq = __uint_as_float(q1 & 0xffff0000u) - lam * (o[d][r + 1] * rb);
      o[d][r] = a; o[d][r + 1] = bq; sa += a * a; sb += bq * bq; }
    sq[r] = sa; sq[r + 1] = sb; }
#pragma unroll
  for (int r = 0; r < 16; ++r) {
#pragma unroll
    for (int of = 1; of < 32; of <<= 1) sq[r] += __shfl_xor(sq[r], of); }
  float* SQX = (float*)(lds + PX_X1);
  if (r32 == 0) {
#pragma unroll
    for (int r = 0; r < 16; ++r) SQX[wid * 32 + crow(r, hi)] = sq[r]; }
  __syncthreads();
#pragma unroll
  for (int r = 0; r < 16; ++r) { const float tot = sq[r] + SQX[pw * 32 + crow(r, hi)]; sq[r] = rsqrtf(tot * (1.f / 256.f) + 1e-6f); }
  char* Wl = lds + wid * 8192 + hi * 1024 + r32 * 2;
#pragma unroll
  for (int r = 0; r < 16; r += 2) {
#pragma unroll
    for (int d0 = 0; d0 < 4; ++d0) {
      const unsigned w = cvtpk(o[d0][r] * sq[r] * gsc[d0], o[d0][r + 1] * sq[r + 1] * gsc[d0]);
      *(unsigned short*)(Wl + crow(r, 0) * 256 + d0 * 64) = (unsigned short)(w & 0xffffu);
      *(unsigned short*)(Wl + crow(r + 1, 0) * 256 + d0 * 64) = (unsigned short)(w >> 16);
    }
    SBAR();
  }
  asm volatile("s_waitcnt lgkmcnt(0)" ::: "memory");
  bf16_t* Ow = Ob + (size_t)(grp * 32) * LDO + role * 128;
#pragma unroll
  for (int i = 0; i < 8; ++i) { const int ch = i * 64 + lane, row = ch >> 4, c16 = ch & 15;
    const u32x4 v = *(const u32x4*)(lds + wid * 8192 + row * 256 + c16 * 16);
    *(u32x4*)(Ow + (size_t)row * LDO + c16 * 8) = v; }
}
#undef SBAR
}

constexpr int DM = 2048, NB = 8, SEQ = 2048, CTXL = 256, TPB = SEQ + CTXL, MT = NB * TPB;
constexpr int FF = 5632, NQKV = 6144, MLA_INP = 1280, MLA_IN = 1088;
constexpr float EPS = 1e-6f;
constexpr int NWAVES = 8;
constexpr int LDS_BYTES = 147456;
constexpr size_t MiB = 1u << 20;
constexpr size_t WS_MOD = 1 * MiB;
constexpr size_t WS_CS0 = 2 * MiB, WS_SN0 = WS_CS0 + 512 * 1024, WS_CS1 = 3 * MiB, WS_SN1 = WS_CS1 + 256 * 1024;
constexpr size_t WS_WQKV = 4 * MiB, WS_WO0 = 28 * MiB, WS_WFI0 = 36 * MiB, WS_WFI1 = 80 * MiB, WS_WFO0 = 124 * MiB, WS_WFO1 = 146 * MiB;
constexpr size_t WS_WMI = 168 * MiB, WS_WQU = 173 * MiB, WS_WKU = 176 * MiB, WS_WMO = 180 * MiB;
constexpr size_t WS_X = 188 * MiB;
constexpr size_t WS_AO = WS_X;
constexpr size_t WS_H = 332 * MiB;
constexpr size_t WS_CQN = WS_H, WS_CKVN = WS_H + 18 * MiB;
constexpr size_t WS_AN = 404 * MiB;
constexpr size_t WS_BIG = 476 * MiB;
constexpr size_t WS_KV1 = WS_BIG, WS_Q1 = WS_BIG + 144 * MiB, WS_CIN = WS_Q1, WS_KR = WS_Q1 + 108 * MiB, WS_END = WS_KR + 3 * MiB;
constexpr size_t WS_SS = 65536;
constexpr size_t WS_BIAS = WS_END, WS_END2 = WS_BIAS + 2 * MiB;
static_assert(WS_END2 <= 768 * MiB, "ws map");

#define GAS __attribute__((address_space(1)))
#define LAS __attribute__((address_space(3)))
typedef unsigned short bf16;
typedef unsigned v4u __attribute__((ext_vector_type(4)));
typedef unsigned v2u __attribute__((ext_vector_type(2)));
typedef float f32x4 __attribute__((ext_vector_type(4)));
#define LDS_WAIT() asm volatile("s_waitcnt lgkmcnt(0)" ::: "memory")
__device__ __forceinline__ unsigned pk2(float lo, float hi) { return pg8::cvt_pk_bf16(lo, hi); }
__device__ __forceinline__ float bf2f(unsigned short s) { return __uint_as_float(((unsigned)s) << 16); }
__device__ __forceinline__ float wave_sum(float v) {
#pragma unroll
    for (int o = 1; o < 64; o <<= 1) v += __shfl_xor(v, o);
    return v;
}

struct Args { const float* in[21]; float* out; unsigned char* ws; int ph_lo, ph_hi, coop, pad; };
enum { I_X = 0, I_C, I_CTX, I_CCTX, I_ADAW, I_ADAB, I_NMG, I_NFG, I_FWI, I_FWO, I_DQKV, I_DLAM, I_DSUB, I_DWO, I_MWI, I_MQG, I_MQU, I_MKG, I_MKU, I_MWO, I_FNG };

struct Frame { unsigned char* lds; unsigned char* ws; const Args* a; int tid, lane, wave, vcu, G; };

__device__ __forceinline__ int qkv_dst(int c) { const int d = c & 127, j = d & 63, n = d >> 6; return c < 4096 ? (c & ~127) + 32 * (j >> 4) + 8 * ((j >> 2) & 3) + 4 * n + (j & 3) : c; }
__device__ __forceinline__ int ffn_dst(int c) { return c < FF ? (c >> 7) * 256 + (c & 127) : ((c - FF) >> 7) * 256 + 128 + ((c - FF) & 127); }
struct TItem { const float* W; bf16* WT; int K, N, dst_n0, src_n0, k0, mode; };
__device__ __forceinline__ TItem titem_decode(const Args& A, unsigned char* ws, int it) {
    constexpr int J0 = (2048 / 64) * (6144 / 64), J1 = (2048 / 64) * (2048 / 64), J2 = (2048 / 64) * (11264 / 64), J4 = (5632 / 64) * (2048 / 64),
                  J6 = (2048 / 64) * (1088 / 64), J7 = (512 / 64) * (3072 / 64), J8 = (512 / 64) * (4096 / 64);
    TItem t; int r = it; t.mode = 0;
    if (r < J0) { const int nb = r % 96, kb = r / 96; t.W = A.in[I_DQKV]; t.WT = (bf16*)(ws + WS_WQKV); t.K = 2048; t.N = 6144; t.dst_n0 = nb * 64; t.src_n0 = nb * 64; t.k0 = kb * 64; t.mode = 1; return t; } r -= J0;
    if (r < J1) { const int nb = r % 32, kb = r / 32; t.W = A.in[I_DWO]; t.WT = (bf16*)(ws + WS_WO0); t.K = 2048; t.N = 2048; t.dst_n0 = nb * 64; t.src_n0 = nb * 64; t.k0 = kb * 64; return t; } r -= J1;
    if (r < 2 * J2) { const int l = r / J2; r -= l * J2; const int nb = r % 176, kb = r / 176; t.W = A.in[I_FWI] + (size_t)l * 2048 * 11264; t.WT = (bf16*)(ws + (l ? WS_WFI1 : WS_WFI0)); t.K = 2048; t.N = 11264;
        t.dst_n0 = ffn_dst(nb * 64); t.src_n0 = nb * 64; t.k0 = kb * 64; return t; } r -= 2 * J2;
    if (r < 2 * J4) { const int l = r / J4; r -= l * J4; const int nb = r % 32, kb = r / 32; t.W = A.in[I_FWO] + (size_t)l * 5632 * 2048; t.WT = (bf16*)(ws + (l ? WS_WFO1 : WS_WFO0)); t.K = 5632; t.N = 2048;
        t.dst_n0 = nb * 64; t.src_n0 = nb * 64; t.k0 = kb * 64; return t; } r -= 2 * J4;
    if (r < J6) { const int nb = r % 17, kb = r / 17; t.W = A.in[I_MWI]; t.WT = (bf16*)(ws + WS_WMI); t.K = 2048; t.N = 1088; t.dst_n0 = nb * 64; t.src_n0 = nb * 64; t.k0 = kb * 64; return t; } r -= J6;
    if (r < J7) { const int nb = r % 48, kb = r / 48; t.W = A.in[I_MQU]; t.WT = (bf16*)(ws + WS_WQU); t.K = 512; t.N = 3072; t.dst_n0 = nb * 64; t.src_n0 = nb * 64; t.k0 = kb * 64; return t; } r -= J7;
    if (r < J8) { const int nb = r % 64, kb = r / 64; t.W = A.in[I_MKU]; t.WT = (bf16*)(ws + WS_WKU); t.K = 512; t.N = 4096; t.dst_n0 = nb * 64; t.src_n0 = nb * 64; t.k0 = kb * 64; return t; } r -= J8;
    { const int nb = r % 32, kb = r / 32; t.W = A.in[I_MWO]; t.WT = (bf16*)(ws + WS_WMO); t.K = 2048; t.N = 2048; t.dst_n0 = nb * 64; t.src_n0 = nb * 64; t.k0 = kb * 64; return t; }
}
__device__ __forceinline__ void titem_load(const TItem& t, f32x4 (&v)[16], int lane) {
    const float* wp = t.W + (size_t)(t.k0 + (lane >> 4)) * t.N + t.src_n0 + (lane & 15) * 4;
#pragma unroll
    for (int i = 0; i < 16; ++i) v[i] = __builtin_nontemporal_load((const f32x4*)(wp + (size_t)(4 * i) * t.N));
}
__device__ __forceinline__ void titem_store(const TItem& t, const f32x4 (&v)[16], LAS float* scr, int lane) {
    LAS float* sw = scr + (lane >> 4) * 65 + (lane & 15) * 4;
#pragma unroll
    for (int i = 0; i < 16; ++i) { sw[(4 * i) * 65 + 0] = v[i].x; sw[(4 * i) * 65 + 1] = v[i].y; sw[(4 * i) * 65 + 2] = v[i].z; sw[(4 * i) * 65 + 3] = v[i].w; }
    LDS_WAIT(); asm volatile("" ::: "memory");
    const int c = lane & 7;
#pragma unroll
    for (int j = 0; j < 8; ++j) { const int n = (lane >> 3) + 8 * j; const LAS float* s = scr + (8 * c) * 65 + n;
        v4u o; o.x = pk2(s[0 * 65], s[1 * 65]); o.y = pk2(s[2 * 65], s[3 * 65]); o.z = pk2(s[4 * 65], s[5 * 65]); o.w = pk2(s[6 * 65], s[7 * 65]);
        const int drow = t.mode ? qkv_dst(t.src_n0 + n) : t.dst_n0 + n;
        *(v4u*)(t.WT + (size_t)drow * t.K + t.k0 + 8 * c) = o; }
    LDS_WAIT(); asm volatile("" ::: "memory");
}

__device__ __forceinline__ void p0_prologue(const Frame& F) {
    const Args& A = *F.a; unsigned char* ws = F.ws;
    LAS float* scr = (LAS float*)(F.lds + F.wave * 16640);
    const int gw = F.vcu * NWAVES + F.wave, NGW = F.G * NWAVES;
    constexpr int NITEMS = (2048 / 64) * (6144 / 64) + 2 * (2048 / 64) * (2048 / 64) + 2 * (2048 / 64) * (11264 / 64) + 2 * (5632 / 64) * (2048 / 64) + (2048 / 64) * (1088 / 64) + (512 / 64) * (3072 / 64) + (512 / 64) * (4096 / 64);
    {
        f32x4 va[16], vb[16]; int it = gw;
        if (it < NITEMS) { TItem ta = titem_decode(A, ws, it); titem_load(ta, va, F.lane);
            for (;;) {
                const int itb = it + NGW; TItem tb = ta; const bool hb = itb < NITEMS; if (hb) { tb = titem_decode(A, ws, itb); titem_load(tb, vb, F.lane); }
                titem_store(ta, va, scr, F.lane); if (!hb) break;
                const int ita = itb + NGW; const bool ha = ita < NITEMS; if (ha) { ta = titem_decode(A, ws, ita); titem_load(ta, va, F.lane); }
                titem_store(tb, vb, scr, F.lane); if (!ha) break;
                it = ita; } }
    }
    const int gt = F.vcu * 512 + F.tid, NGT = F.G * 512;
    { v4u* z = (v4u*)((bf16*)(ws + WS_WMI) + (size_t)MLA_IN * 2048); const int nz = (MLA_INP - MLA_IN) * 2048 / 8;
      for (int i = gt; i < nz; i += NGT) z[i] = (v4u){0u, 0u, 0u, 0u}; }
    { float* ssz = (float*)(ws + WS_SS); for (int i = gt; i < 3 * MT; i += NGT) ssz[i] = 0.f; }
    for (int i = gt; i < 2048 * 96; i += NGT) {
        const bool l1 = i >= 2048 * 64; const int k = l1 ? i - 2048 * 64 : i; const int nf = l1 ? 16 : 32; const int t = k / (2 * nf), j = k % (2 * nf);
        const float pos = (float)(j < nf ? t / 64 : t % 64); const int f = j < nf ? j : j - nf;
        const float inv = exp2f(-(float)f / (float)nf * 13.287712379549449f);
        const float ang = pos * inv; double rv = (double)ang * 0.15915494309189535; rv -= floor(rv); const float rf = (float)rv;
        const float cv = __builtin_amdgcn_cosf(rf), sv = __builtin_amdgcn_sinf(rf);
        if (l1) { ((float*)(ws + WS_CS1))[k] = cv; ((float*)(ws + WS_SN1))[k] = sv; } else { ((float*)(ws + WS_CS0))[k] = cv; ((float*)(ws + WS_SN0))[k] = sv; }
    }
    __syncthreads();
    LAS float* sc = (LAS float*)F.lds; LAS float* red = (LAS float*)(F.lds + 9 * 2048 * 4);
    for (int i = F.tid; i < 9 * 2048; i += 512) { const int r = i >> 11, k = i & 2047; const float v = r < 8 ? A.in[I_C][r * 2048 + k] : A.in[I_CCTX][k]; sc[i] = v / (1.f + expf(-v)); }
    __syncthreads();
    for (int u = blockIdx.x; u < 768; u += F.G) {
        const int layer = u / 384, n0 = (u % 384) * 32, c4 = F.tid & 7, kg = F.tid >> 3;
        const float* w = A.in[I_ADAW] + (size_t)layer * 2048 * 12288 + (size_t)(kg * 32) * 12288 + n0 + c4 * 4;
        f32x4 acc[9];
#pragma unroll
        for (int r = 0; r < 9; ++r) acc[r] = (f32x4){0.f, 0.f, 0.f, 0.f};
#pragma unroll
        for (int k = 0; k < 32; k += 8) {
            f32x4 wv[8];
#pragma unroll
            for (int q = 0; q < 8; ++q) wv[q] = __builtin_nontemporal_load((const f32x4*)(w + (size_t)(k + q) * 12288));
#pragma unroll
            for (int r = 0; r < 9; ++r) { const f32x4 s0 = *(const LAS f32x4*)(sc + r * 2048 + kg * 32 + k), s1 = *(const LAS f32x4*)(sc + r * 2048 + kg * 32 + k + 4);
                acc[r] += (wv[0] * s0.x + wv[1] * s0.y) + (wv[2] * s0.z + wv[3] * s0.w) + (wv[4] * s1.x + wv[5] * s1.y) + (wv[6] * s1.z + wv[7] * s1.w); }
        }
#pragma unroll
        for (int r = 0; r < 9; ++r) {
#pragma unroll
            for (int e = 0; e < 4; ++e) { float x = acc[r][e]; x += __shfl_xor(x, 8); x += __shfl_xor(x, 16); x += __shfl_xor(x, 32); acc[r][e] = x; } }
        if (F.lane < 8) {
#pragma unroll
            for (int r = 0; r < 9; ++r) *(LAS f32x4*)(red + (F.wave * 9 + r) * 32 + c4 * 4) = acc[r]; }
        __syncthreads();
        if (F.tid < 288) { const int r = F.tid >> 5, c2 = F.tid & 31; float s = 0.f;
#pragma unroll
            for (int g = 0; g < 8; ++g) s += red[(g * 9 + r) * 32 + c2];
            ((float*)(ws + WS_MOD))[(size_t)(layer * 9 + r) * 12288 + n0 + c2] = s + A.in[I_ADAB][layer * 12288 + n0 + c2]; }
        __syncthreads();
    }
}

__device__ __forceinline__ void norm_phase(const Frame& F, int layer, int which, bool from_input, bool lat_only) {
    const Args& A = *F.a; const int gw = F.vcu * NWAVES + F.wave, NGW = F.G * NWAVES;
    const float* g = (which ? A.in[I_NFG] : A.in[I_NMG]) + layer * 2048;
    const float* X = (const float*)(F.ws + WS_X); bf16* H = (bf16*)(F.ws + WS_H);
    for (int m0 = gw; m0 < MT; m0 += 2 * NGW) {
        f32x4 v[2][8]; const float* shift[2]; bool ok[2]; int mm[2];
#pragma unroll
        for (int q = 0; q < 2; ++q) { const int m = m0 + q * NGW; mm[q] = m; const int b = m / TPB, r = m - b * TPB; ok[q] = m < MT && !(lat_only && r < CTXL);
            const float* src = from_input ? (r < CTXL ? A.in[I_CTX] + ((size_t)b * CTXL + r) * 2048 : A.in[I_X] + ((size_t)b * SEQ + (r - CTXL)) * 2048) : X + (size_t)m * 2048;
            shift[q] = (const float*)(F.ws + WS_MOD) + (size_t)(layer * 9 + (r < CTXL ? 8 : b)) * 12288 + which * 3 * 2048;
            if (ok[q]) { const f32x4* xr = (const f32x4*)src + F.lane;
#pragma unroll
                for (int j = 0; j < 8; ++j) v[q][j] = from_input ? __builtin_nontemporal_load(xr + 64 * j) : xr[64 * j]; } }
#pragma unroll
        for (int q = 0; q < 2; ++q) if (ok[q]) { float s = 0.f;
#pragma unroll
            for (int j = 0; j < 8; ++j) s += (v[q][j].x * v[q][j].x + v[q][j].y * v[q][j].y) + (v[q][j].z * v[q][j].z + v[q][j].w * v[q][j].w);
            const float rstd = rsqrtf(wave_sum(s) * (1.f / 2048.f) + EPS); const float* scale = shift[q] + 2048;
            v2u* o8 = (v2u*)(H + (size_t)mm[q] * 2048) + F.lane;
#pragma unroll
            for (int j = 0; j < 8; ++j) { const f32x4 gg = ((const f32x4*)g)[64 * j + F.lane], sc = ((const f32x4*)scale)[64 * j + F.lane], sh = ((const f32x4*)shift[q])[64 * j + F.lane];
                const f32x4 y = (v[q][j] * rstd * gg) * (sc + 1.f) + sh; v2u w; w.x = pk2(y.x, y.y); w.y = pk2(y.z, y.w); o8[64 * j] = w; } }
    }
}

__device__ __forceinline__ void bias_phase(const Frame& F) {
    const int gw = F.vcu * NWAVES + F.wave, NGW = F.G * NWAVES; const int fr = F.lane & 15, fq = F.lane >> 4;
    const float* MOD = (const float*)(F.ws + WS_MOD); float* BIAS = (float*)(F.ws + WS_BIAS);
    constexpr int NB0 = 11264 / 16, NB1 = MLA_INP / 16, NBT = 2 * NB0 + NB1;
    for (int it = gw; it < NBT; it += NGW) {
        int j, nb; if (it < NB0) { j = 0; nb = it; } else if (it < NB0 + NB1) { j = 1; nb = it - NB0; } else { j = 2; nb = it - NB0 - NB1; }
        const bf16* Wt = (const bf16*)(F.ws + (j == 0 ? WS_WFI0 : j == 1 ? WS_WMI : WS_WFI1)); const int N = j == 1 ? MLA_INP : 11264;
        const float* sh = MOD + (size_t)((j ? 9 : 0) + (fr < 9 ? fr : 0)) * 12288 + (j == 1 ? 0 : 3 * 2048) + fq * 8;
        const bf16* wp = Wt + (size_t)(nb * 16 + fr) * 2048 + fq * 8;
        pg8::f32x4 acc = {0.f, 0.f, 0.f, 0.f};
#pragma unroll 4
        for (int k0 = 0; k0 < 2048; k0 += 32) {
            const pg8::bf16x8 a = *(const pg8::bf16x8*)(wp + k0);
            v4u bw = {0u, 0u, 0u, 0u};
            if (fr < 9) { const f32x4 s0 = *(const f32x4*)(sh + k0), s1 = *(const f32x4*)(sh + k0 + 4); bw.x = pk2(s0.x, s0.y); bw.y = pk2(s0.z, s0.w); bw.z = pk2(s1.x, s1.y); bw.w = pk2(s1.z, s1.w); }
            acc = __builtin_amdgcn_mfma_f32_16x16x32_bf16(a, *(pg8::bf16x8*)&bw, acc, 0, 0, 0);
        }
        if (fr < 9) *(f32x4*)(BIAS + ((size_t)j * 9 + fr) * 11264 + nb * 16 + fq * 4) = acc;
    }
}

__device__ __forceinline__ void rope0_phase(const Frame& F) {
    const int gw = F.vcu * NWAVES + F.wave, NGW = F.G * NWAVES;
    bf16* QKV = (bf16*)(F.ws + WS_BIG); const float* CS = (const float*)(F.ws + WS_CS0); const float* SN = (const float*)(F.ws + WS_SN0);
    for (int lr = gw; lr < NB * SEQ; lr += NGW) {
        const int b = lr >> 11, t = lr & 2047; bf16* row = QKV + ((size_t)b * TPB + CTXL + t) * NQKV;
#pragma unroll
        for (int it = 0; it < 4; ++it) { const int idx = it * 64 + F.lane, grp = idx >> 3, j0 = (idx & 7) * 8;
            v4u a = *(const v4u*)(row + grp * 128 + j0), bq = *(const v4u*)(row + grp * 128 + 64 + j0);
            const f32x4 c0 = *(const f32x4*)(CS + t * 64 + j0), c1 = *(const f32x4*)(CS + t * 64 + j0 + 4), s0 = *(const f32x4*)(SN + t * 64 + j0), s1 = *(const f32x4*)(SN + t * 64 + j0 + 4);
            v4u oa, ob;
#pragma unroll
            for (int q = 0; q < 4; ++q) {
                const float x1l = __uint_as_float(a[q] << 16), x1h = __uint_as_float(a[q] & 0xffff0000u), x2l = __uint_as_float(bq[q] << 16), x2h = __uint_as_float(bq[q] & 0xffff0000u);
                const float cl = q < 2 ? c0[2 * q] : c1[2 * q - 4], ch = q < 2 ? c0[2 * q + 1] : c1[2 * q - 3], sl = q < 2 ? s0[2 * q] : s1[2 * q - 4], sh = q < 2 ? s0[2 * q + 1] : s1[2 * q - 3];
                oa[q] = pk2(x1l * cl - x2l * sl, x1h * ch - x2h * sh); ob[q] = pk2(x1l * sl + x2l * cl, x1h * sh + x2h * ch); }
            *(v4u*)(row + grp * 128 + j0) = oa; *(v4u*)(row + grp * 128 + 64 + j0) = ob; }
    }
}

__device__ __forceinline__ void combine_phase(const Frame& F) {
    const Args& A = *F.a; const int gw = F.vcu * NWAVES + F.wave, NGW = F.G * NWAVES;
    const float* lv = A.in[I_DLAM];
    const float s1 = wave_sum(lv[F.lane] * lv[128 + F.lane] + lv[64 + F.lane] * lv[192 + F.lane]);
    const float s2 = wave_sum(lv[256 + F.lane] * lv[384 + F.lane] + lv[320 + F.lane] * lv[448 + F.lane]);
    const float lam_init = 0.2f, lam = expf(s1) - expf(s2) + lam_init;
    const int l32 = F.lane & 31; const bool lo = F.lane < 32;
    const f32x4 g0 = ((const f32x4*)A.in[I_DSUB])[2 * l32], g1 = ((const f32x4*)A.in[I_DSUB])[2 * l32 + 1];
    const bf16* AO = (const bf16*)(F.ws + WS_AO); bf16* AN = (bf16*)(F.ws + WS_AN);
    for (int m = gw; m < MT; m += NGW) {
        v4u a[8];
#pragma unroll
        for (int h = 0; h < 8; ++h) a[h] = *((const v4u*)(AO + (size_t)m * 4096 + h * 512) + F.lane);
#pragma unroll
        for (int h = 0; h < 8; ++h) {
            v4u o; float d[8]; float ss = 0.f;
#pragma unroll
            for (int q = 0; q < 4; ++q) { o[q] = __shfl_xor((int)a[h][q], 32); }
#pragma unroll
            for (int q = 0; q < 4; ++q) { const unsigned p1 = lo ? a[h][q] : o[q], p2 = lo ? o[q] : a[h][q];
                d[2 * q] = __uint_as_float(p1 << 16) - lam * __uint_as_float(p2 << 16); d[2 * q + 1] = __uint_as_float(p1 & 0xffff0000u) - lam * __uint_as_float(p2 & 0xffff0000u);
                ss += d[2 * q] * d[2 * q] + d[2 * q + 1] * d[2 * q + 1]; }
#pragma unroll
            for (int of = 1; of < 32; of <<= 1) ss += __shfl_xor(ss, of);
            const float rstd = rsqrtf(ss * (1.f / 256.f) + EPS) * (1.f - lam_init);
            v4u w; w.x = pk2(d[0] * rstd * g0.x, d[1] * rstd * g0.y); w.y = pk2(d[2] * rstd * g0.z, d[3] * rstd * g0.w);
            w.z = pk2(d[4] * rstd * g1.x, d[5] * rstd * g1.y); w.w = pk2(d[6] * rstd * g1.z, d[7] * rstd * g1.w);
            if (lo) *((v4u*)(AN + (size_t)m * 2048 + h * 256) + l32) = w;
        }
    }
}

__device__ __forceinline__ void mla_norm_phase(const Frame& F) {
    const Args& A = *F.a; const int gw = F.vcu * NWAVES + F.wave, NGW = F.G * NWAVES;
    const bf16* CIN = (const bf16*)(F.ws + WS_CIN); bf16* CQN = (bf16*)(F.ws + WS_CQN); bf16* CKVN = (bf16*)(F.ws + WS_CKVN); bf16* KR = (bf16*)(F.ws + WS_KR);
    const float* CS = (const float*)(F.ws + WS_CS1); const float* SN = (const float*)(F.ws + WS_SN1);
    const f32x4 gq0 = ((const f32x4*)A.in[I_MQG])[2 * F.lane], gq1 = ((const f32x4*)A.in[I_MQG])[2 * F.lane + 1];
    const f32x4 gk0 = ((const f32x4*)A.in[I_MKG])[2 * F.lane], gk1 = ((const f32x4*)A.in[I_MKG])[2 * F.lane + 1];
    for (int m = gw; m < MT; m += NGW) {
        const bf16* row = CIN + (size_t)m * MLA_INP;
#pragma unroll
        for (int p = 0; p < 2; ++p) {
            const v4u a = *((const v4u*)(row + p * 512) + F.lane); float x[8];
#pragma unroll
            for (int q = 0; q < 4; ++q) { x[2 * q] = __uint_as_float(a[q] << 16); x[2 * q + 1] = __uint_as_float(a[q] & 0xffff0000u); }
            float s = 0.f;
#pragma unroll
            for (int e = 0; e < 8; ++e) s += x[e] * x[e];
            const float rstd = rsqrtf(wave_sum(s) * (1.f / 512.f) + EPS);
            const f32x4 g0 = p ? gk0 : gq0, g1 = p ? gk1 : gq1;
            v4u w; w.x = pk2(x[0] * rstd * g0.x, x[1] * rstd * g0.y); w.y = pk2(x[2] * rstd * g0.z, x[3] * rstd * g0.w);
            w.z = pk2(x[4] * rstd * g1.x, x[5] * rstd * g1.y); w.w = pk2(x[6] * rstd * g1.z, x[7] * rstd * g1.w);
            *((v4u*)((p ? CKVN : CQN) + (size_t)m * 512) + F.lane) = w;
        }
        const int b = m / TPB, r = m - b * TPB;
        if (F.lane < 4) {
            const v4u a = *((const v4u*)(row + 1024) + F.lane), bq = *((const v4u*)(row + 1024 + 32) + F.lane);
            v4u oa = a, ob = bq;
            if (r >= CTXL) { const int t = r - CTXL, j0 = F.lane * 8;
                const f32x4 c0 = *(const f32x4*)(CS + t * 32 + j0), c1 = *(const f32x4*)(CS + t * 32 + j0 + 4), s0 = *(const f32x4*)(SN + t * 32 + j0), s1 = *(const f32x4*)(SN + t * 32 + j0 + 4);
#pragma unroll
                for (int q = 0; q < 4; ++q) {
                    const float x1l = __uint_as_float(a[q] << 16), x1h = __uint_as_float(a[q] & 0xffff0000u), x2l = __uint_as_float(bq[q] << 16), x2h = __uint_as_float(bq[q] & 0xffff0000u);
                    const float cl = q < 2 ? c0[2 * q] : c1[2 * q - 4], ch = q < 2 ? c0[2 * q + 1] : c1[2 * q - 3], sl = q < 2 ? s0[2 * q] : s1[2 * q - 4], sh = q < 2 ? s0[2 * q + 1] : s1[2 * q - 3];
                    oa[q] = pk2(x1l * cl - x2l * sl, x1h * ch - x2h * sh); ob[q] = pk2(x1l * sl + x2l * cl, x1h * sh + x2h * ch); } }
            *((v4u*)(KR + (size_t)m * 64) + F.lane) = oa; *((v4u*)(KR + (size_t)m * 64 + 32) + F.lane) = ob;
        }
    }
}

__device__ __forceinline__ void final_phase(const Frame& F) {
    const Args& A = *F.a; const int gw = F.vcu * NWAVES + F.wave, NGW = F.G * NWAVES;
    const float* X = (const float*)(F.ws + WS_X); const float* g = A.in[I_FNG];
    for (int lr0 = gw; lr0 < NB * SEQ; lr0 += 2 * NGW) {
        f32x4 v[2][8];
#pragma unroll
        for (int q = 0; q < 2; ++q) { const int lr = lr0 + q * NGW; if (lr < NB * SEQ) { const int b = lr >> 11, t = lr & 2047; const f32x4* xr = (const f32x4*)(X + ((size_t)b * TPB + CTXL + t) * 2048) + F.lane;
#pragma unroll
            for (int j = 0; j < 8; ++j) v[q][j] = xr[64 * j]; } }
#pragma unroll
        for (int q = 0; q < 2; ++q) { const int lr = lr0 + q * NGW; if (lr < NB * SEQ) { float s = 0.f;
#pragma unroll
            for (int j = 0; j < 8; ++j) s += (v[q][j].x * v[q][j].x + v[q][j].y * v[q][j].y) + (v[q][j].z * v[q][j].z + v[q][j].w * v[q][j].w);
            const float rstd = rsqrtf(wave_sum(s) * (1.f / 2048.f) + EPS);
            f32x4* o = (f32x4*)(A.out + (size_t)lr * 2048) + F.lane;
#pragma unroll
            for (int j = 0; j < 8; ++j) __builtin_nontemporal_store(v[q][j] * rstd * ((const f32x4*)g)[64 * j + F.lane], o + 64 * j); } }
    }
}

__device__ __forceinline__ void attn0_phase(const Frame& F) {
    const bf16* QKV = (const bf16*)(F.ws + WS_BIG); bf16* AO = (bf16*)(F.ws + WS_AO);
#if ATT0_PX
    const Args& A = *F.a; const float* lv = A.in[I_DLAM];
    const float s1 = wave_sum(lv[F.lane] * lv[128 + F.lane] + lv[64 + F.lane] * lv[192 + F.lane]);
    const float s2 = wave_sum(lv[256 + F.lane] * lv[384 + F.lane] + lv[320 + F.lane] * lv[448 + F.lane]);
    const float lam = expf(s1) - expf(s2) + 0.2f;
    bf16* AN = (bf16*)(F.ws + WS_AN);
    for (int li = F.vcu; li < 1024 + 128; li += F.G) {
        int b, h, qrow0, seq;
        if (li < 1024) { const int qb = li & 15; h = (li >> 4) & 7; b = li >> 7; qrow0 = b * TPB + CTXL + qb * 128; seq = TPB; }
        else { const int ci = li - 1024; const int qb = ci & 1; h = (ci >> 1) & 7; b = ci >> 4; qrow0 = b * TPB + qb * 128; seq = CTXL; }
        const bf16* kb = QKV + (size_t)b * TPB * NQKV;
        att::attn_px_body(QKV + (size_t)qrow0 * NQKV + h * 256, kb + 2048 + h * 256, kb + 4096 + h * 256, AN + (size_t)qrow0 * 2048 + h * 256, seq, lam, A.in[I_DSUB], (unsigned*)(F.ws + WS_AO) + (size_t)blockIdx.x * 16384, (char*)F.lds);
    }
#else
    for (int li = F.vcu; li < 2048 + 256; li += F.G) {
        int b, mp, vh, qrow0, seq;
        if (li < 2048) { const int qb = li & 7; vh = (li >> 3) & 1; mp = (li >> 4) & 15; b = li >> 8; qrow0 = b * TPB + CTXL + qb * 256; seq = TPB; }
        else { const int ci = li - 2048; vh = ci & 1; mp = (ci >> 1) & 15; b = ci >> 5; qrow0 = b * TPB; seq = CTXL; }
        const bf16* kb = QKV + (size_t)b * TPB * NQKV;
        att::attn_body<128, ATT0_SDEPTH, NQKV, NQKV, NQKV, 4096>(QKV + (size_t)qrow0 * NQKV + mp * 128, kb + 2048 + mp * 128, nullptr, kb + 4096 + (mp >> 1) * 256 + vh * 128,
                               AO + (size_t)qrow0 * 4096 + mp * 256 + vh * 128, seq, nullptr, nullptr, (char*)F.lds);
    }
#endif
}
__device__ __forceinline__ void attn1_phase(const Frame& F) {
    const bf16* Q1 = (const bf16*)(F.ws + WS_Q1); const bf16* KV1 = (const bf16*)(F.ws + WS_KV1); const bf16* KR = (const bf16*)(F.ws + WS_KR); bf16* AN = (bf16*)(F.ws + WS_AN);
    const float* CS = (const float*)(F.ws + WS_CS1); const float* SN = (const float*)(F.ws + WS_SN1);
    for (int li = F.vcu; li < 1024; li += F.G) {
        const int qb = li & 7, h = (li >> 3) & 15, b = li >> 7; const int qrow0 = b * TPB + CTXL + qb * 256;
        const bf16* kb = KV1 + (size_t)b * TPB * 4096 + h * 256;
        att::attn_body<192, ATT1_SDEPTH, 3072, 4096, 4096, 2048>(Q1 + (size_t)qrow0 * 3072 + h * 192, kb, KR + (size_t)b * TPB * 64, kb + 128,
                                         AN + (size_t)qrow0 * 2048 + h * 128, TPB, CS + (size_t)qb * 256 * 32, SN + (size_t)qb * 256 * 32, (char*)F.lds);
    }
}

#define XB_TMO      128
#define XB_XCNT(j)  (256  + 64 * (j))
#define XB_XSUB(j)  (1280 + 64 * (j))
#define XB_XGEN(j)  (2304 + 64 * (j))
#define XB_TOP      3328
#define XB_TOPGEN   3392
#define XCD_BAR_WORDS 3456
#define XB_SPIN_CAP (1u << 18)

__device__ __forceinline__ unsigned xb_ld(unsigned* p)              { return __hip_atomic_load(p, __ATOMIC_RELAXED, __HIP_MEMORY_SCOPE_AGENT); }
__device__ __forceinline__ unsigned xb_add(unsigned* p, unsigned v) { return __hip_atomic_fetch_add(p, v, __ATOMIC_RELAXED, __HIP_MEMORY_SCOPE_AGENT); }
__device__ __forceinline__ unsigned xb_xcc_id() { return (unsigned)__builtin_amdgcn_s_getreg((3 << 11) | 20) & 0xFu; }
#define XB_SPIN(cond, bar) do { unsigned _sp = 0; while (cond) { __builtin_amdgcn_s_sleep(1); \
    if ((++_sp & 255u) == 0u) { if (xb_ld(&(bar)[XB_TMO])) break; if (_sp > XB_SPIN_CAP) { atomicAdd(&(bar)[XB_TMO], 1u); break; } } } } while (0)

struct XcdBarrier {
    unsigned* bar; unsigned x;
    volatile LAS unsigned* st;
};

__device__ __forceinline__ XcdBarrier xcd_barrier_post(unsigned* bar, volatile LAS unsigned* st) {
    XcdBarrier b; b.bar = bar; b.x = xb_xcc_id(); b.st = st;
    if (threadIdx.x == 0) (void)xb_add(&bar[XB_XCNT(b.x)], 1u);
    return b;
}
__device__ __forceinline__ void xcd_barrier_complete(unsigned* bar, unsigned x, unsigned& nloc, unsigned& nx) {
    const unsigned G = gridDim.x * gridDim.y * gridDim.z;
    unsigned sum, cnt, mine, sp = 0u;
    for (;;) {
        sum = 0u; cnt = 0u; mine = 0u;
#pragma unroll
        for (unsigned j = 0; j < 16; ++j) { const unsigned c = xb_ld(&bar[XB_XCNT(j)]); sum += c; cnt += (c > 0u) ? 1u : 0u; mine = (j == x) ? c : mine; }
        if (sum == G) break;
        __builtin_amdgcn_s_sleep(1);
        if ((++sp & 255u) == 0u) { if (xb_ld(&bar[XB_TMO])) break; if (sp > XB_SPIN_CAP) { atomicAdd(&bar[XB_TMO], 1u); break; } }
    }
    nloc = mine > 0u ? mine : 1u; nx = cnt > 0u ? cnt : 1u;
}

__device__ __forceinline__ void xcd_barrier(const XcdBarrier& b) {
    asm volatile("s_waitcnt vmcnt(0)" ::: "memory");
    __syncthreads();
    if (threadIdx.x == 0) {
        unsigned* bar = b.bar;
        __builtin_amdgcn_s_waitcnt(0);
        unsigned nloc = b.st[0], nx = b.st[1];
        if (nloc == 0u) { xcd_barrier_complete(bar, b.x, nloc, nx); b.st[0] = nloc; b.st[1] = nx; }
        const unsigned old = xb_add(&bar[XB_XSUB(b.x)], 1u);
        const unsigned gen = old / nloc;
        if (old + 1u == (gen + 1u) * nloc) {
            __builtin_amdgcn_fence(__ATOMIC_RELEASE, "agent");
            asm volatile("s_waitcnt vmcnt(0)" ::: "memory");
            const unsigned og = xb_add(&bar[XB_TOP], 1u);
            const unsigned tg = og / nx;
            if (og + 1u == (tg + 1u) * nx) xb_add(&bar[XB_TOPGEN], 1u);
            else XB_SPIN(xb_ld(&bar[XB_TOPGEN]) == tg, bar);
            __builtin_amdgcn_fence(__ATOMIC_ACQUIRE, "agent");
            xb_add(&bar[XB_XGEN(b.x)], 1u);
            asm volatile("s_waitcnt vmcnt(0)" ::: "memory");
        } else {
            XB_SPIN(xb_ld(&bar[XB_XGEN(b.x)]) == gen, bar);
            __builtin_amdgcn_fence(__ATOMIC_ACQUIRE, "agent");
            asm volatile("s_waitcnt vmcnt(0)" ::: "memory");
        }
    }
    __syncthreads();
}

constexpr int NPH = 20;
__global__ void __launch_bounds__(NWAVES * 64, 2) fwd_mega(Args args) {
    extern __shared__ __attribute__((aligned(16))) unsigned char lds[];
    Frame F; F.lds = lds; F.ws = args.ws; F.a = &args;
#define REFRESH() do { F.tid = fresh_tid(); F.lane = F.tid & 63; F.wave = __builtin_amdgcn_readfirstlane(F.tid >> 6); } while (0)
    REFRESH();
    F.G = gridDim.x; { const int bx = blockIdx.x; F.vcu = (F.G % 8 == 0) ? (bx % 8) * (F.G / 8) + bx / 8 : bx; }
    const int lo = args.ph_lo, hi = args.ph_hi;
    unsigned char* ws = args.ws; float* MOD = (float*)(ws + WS_MOD); float* SSQ = (float*)(ws + WS_SS); const float* BIAS = (const float*)(ws + WS_BIAS);
    PG8_LAS unsigned char* glds = (PG8_LAS unsigned char*)lds;
#define IN(k) (lo <= (k) && (k) < hi)
#if PROBE_MASK
    unsigned long long t_acc = 0, t_prev = __builtin_amdgcn_s_memrealtime();
#define PROBE_AT(k) do { const unsigned long long now_ = __builtin_amdgcn_s_memrealtime(); if ((PROBE_MASK >> (k)) & 1) t_acc += now_ - t_prev; t_prev = now_; } while (0)
#else
#define PROBE_AT(k) do { } while (0)
#endif
#define SEAM(k) do { if (IN(k) && IN((k) + 1)) xcd_barrier(bar); } while (0)
#define DBL(k) (((PROBE_DBL >> (k)) & 1) ? 2 : 1)
    unsigned* barw = (unsigned*)(ws + 4096);
    volatile LAS unsigned* bst = (volatile LAS unsigned*)((LAS unsigned char*)lds + LDS_BYTES - 16);
    XcdBarrier bar; bar.bar = barw; bar.x = 0; bar.st = bst;
    if (args.coop) {
        if (threadIdx.x < 2) bst[threadIdx.x] = 0u;
        __syncthreads();
        if (args.coop == 2) cg::this_grid().sync();
        bar = xcd_barrier_post(barw, bst);
    }
#define GEMM_PHASE(EPI, Aoff, Boff, M_, N_, K_, LAT, ...) do { pg8::Gemm g{(const bf16*)(ws + (Aoff)), (const bf16*)(ws + (Boff)), M_, N_, K_}; pg8::StaticOrder S; S.init(M_, N_, F.G, (int)blockIdx.x, LAT); \
        pg8::EPI E{__VA_ARGS__}; pg8::gemm_phase<pg8::EPI, pg8::StaticOrder, true, true>(glds, g, S, E); } while (0)

    if (IN(0)) for (int rep_ = 0; rep_ < DBL(0); ++rep_) { REFRESH(); p0_prologue(F); } SEAM(0);
    if (IN(1)) for (int rep_ = 0; rep_ < DBL(1); ++rep_) { REFRESH(); norm_phase(F, 0, 0, true, false); bias_phase(F); } SEAM(1);
    if (IN(2)) for (int rep_ = 0; rep_ < DBL(2); ++rep_) { GEMM_PHASE(EpiQKV, WS_H, WS_WQKV, MT, NQKV, 2048, 0, (bf16*)(ws + WS_BIG), NQKV, (const float*)(ws + WS_CS0), (const float*)(ws + WS_SN0)); } SEAM(2);
    if (IN(4)) for (int rep_ = 0; rep_ < DBL(4); ++rep_) { REFRESH(); attn0_phase(F); } SEAM(4);
    if (IN(5)) for (int rep_ = 0; rep_ < DBL(5); ++rep_) { REFRESH(); if (!ATT0_PX) combine_phase(F); } if (!ATT0_PX) SEAM(5);
    if (IN(6)) { GEMM_PHASE(EpiRes, WS_AN, WS_WO0, MT, 2048, 2048, 0, (float*)(ws + WS_X), args.in[I_X], args.in[I_CTX], MOD + 2 * 2048, (bf16*)(ws + WS_H), args.in[I_NFG], MOD + 4 * 2048, SSQ); } SEAM(6);
    if (IN(8)) for (int rep_ = 0; rep_ < DBL(8); ++rep_) { GEMM_PHASE(EpiSwiGLU, WS_H, WS_WFI0, MT, 2 * FF, 2048, 0, (bf16*)(ws + WS_BIG), FF, SSQ, BIAS); } SEAM(8);
    if (IN(9)) { GEMM_PHASE(EpiRes, WS_BIG, WS_WFO0, MT, 2048, FF, 0, (float*)(ws + WS_X), nullptr, nullptr, MOD + 5 * 2048, (bf16*)(ws + WS_H), args.in[I_NMG] + 2048, MOD + 9 * 12288 + 1 * 2048, SSQ + MT); } SEAM(9);
    if (IN(11)) for (int rep_ = 0; rep_ < DBL(11); ++rep_) { GEMM_PHASE(EpiBf16, WS_H, WS_WMI, MT, MLA_INP, 2048, 0, (bf16*)(ws + WS_CIN), MLA_INP, SSQ + MT, BIAS + 9 * 11264, 11264); } SEAM(11);
    if (IN(12)) for (int rep_ = 0; rep_ < DBL(12); ++rep_) { REFRESH(); mla_norm_phase(F); } SEAM(12);
    if (IN(13)) for (int rep_ = 0; rep_ < DBL(13); ++rep_) { GEMM_PHASE(EpiBf16, WS_CKVN, WS_WKU, MT, 4096, 512, 0, (bf16*)(ws + WS_KV1), 4096, nullptr, nullptr, 0);
                  GEMM_PHASE(EpiBf16, WS_CQN, WS_WQU, MT, 3072, 512, 1, (bf16*)(ws + WS_Q1), 3072, nullptr, nullptr, 0); } SEAM(13);
    if (IN(14)) for (int rep_ = 0; rep_ < DBL(14); ++rep_) { REFRESH(); attn1_phase(F); } SEAM(14);
    if (IN(15)) { GEMM_PHASE(EpiRes, WS_AN, WS_WMO, MT, 2048, 2048, 1, (float*)(ws + WS_X), nullptr, nullptr, MOD + 9 * 12288 + 2 * 2048, (bf16*)(ws + WS_H), args.in[I_NFG] + 2048, MOD + 9 * 12288 + 4 * 2048, SSQ + 2 * MT); } SEAM(15);
    if (IN(17)) for (int rep_ = 0; rep_ < DBL(17); ++rep_) { GEMM_PHASE(EpiSwiGLU, WS_H, WS_WFI1, MT, 2 * FF, 2048, 1, (bf16*)(ws + WS_BIG), FF, SSQ + 2 * MT, BIAS + 2 * 9 * 11264); } SEAM(17);
    if (IN(18)) { GEMM_PHASE(EpiRes, WS_BIG, WS_WFO1, MT, 2048, FF, 1, (float*)(ws + WS_X), nullptr, nullptr, MOD + 9 * 12288 + 5 * 2048, nullptr, nullptr, nullptr, nullptr); } SEAM(18);
    if (IN(19)) for (int rep_ = 0; rep_ < DBL(19); ++rep_) { REFRESH(); final_phase(F); }
#if PROBE_MASK
    __syncthreads(); PROBE_AT(19);
    if (blockIdx.x == 0 && threadIdx.x == 0) args.out[0] = (float)t_acc * 0.01f;
#endif
#undef IN
#undef SEAM
#undef GEMM_PHASE
}

extern "C" void kernel_launch(void* const* d_in, const int* in_sizes, int n_in, void* d_out, int out_size, void* d_ws, size_t ws_size, hipStream_t stream) {
    static int grid = 0;
    if (grid == 0) {
        if (n_in != 21 || in_sizes[0] != NB * SEQ * DM || out_size != NB * SEQ * DM || ws_size < WS_END2) {
            fprintf(stderr, "kernel_launch: shape mismatch (n_in %d in0 %d out %d ws %zu, need ws >= %zu); nothing launched\n", n_in, n_in > 0 ? in_sizes[0] : -1, out_size, ws_size, (size_t)WS_END2); grid = -1; return; }
        int dev = 0, cus = 0, per_cu = 0;
        if (hipGetDevice(&dev) != hipSuccess || hipDeviceGetAttribute(&cus, hipDeviceAttributeMultiprocessorCount, dev) != hipSuccess) { fprintf(stderr, "kernel_launch: device query failed\n"); grid = -1; return; }
        if (hipFuncSetAttribute((const void*)fwd_mega, hipFuncAttributeMaxDynamicSharedMemorySize, LDS_BYTES) != hipSuccess) { fprintf(stderr, "kernel_launch: hipFuncSetAttribute failed\n"); grid = -1; return; }
        if (hipOccupancyMaxActiveBlocksPerMultiprocessor(&per_cu, (const void*)fwd_mega, NWAVES * 64, LDS_BYTES) != hipSuccess || per_cu < 1) { fprintf(stderr, "kernel_launch: occupancy query says %d\n", per_cu); per_cu = 1; }
        (void)hipGetLastError();
        grid = cus * 1;
    }
    if (grid < 0) return;
    Args a{};
    for (int i = 0; i < 21; ++i) a.in[i] = (const float*)d_in[i];
    a.out = (float*)d_out; a.ws = (unsigned char*)d_ws;
#if ONE_LAUNCH
    a.ph_lo = 0; a.ph_hi = NPH; a.coop = 1;
    if (hipMemsetAsync((char*)d_ws + 4096, 0, XCD_BAR_WORDS * 4, stream) != hipSuccess) { fprintf(stderr, "kernel_launch: hipMemsetAsync of the barrier words failed\n"); return; }
    void* kargs[] = {&a};
    hipError_t e = hipLaunchCooperativeKernel((const void*)fwd_mega, dim3(grid), dim3(NWAVES * 64), kargs, LDS_BYTES, stream);
    if (e != hipSuccess) fprintf(stderr, "kernel_launch: cooperative launch failed: %s (grid %d)\n", hipGetErrorString(e), grid);
#else
    for (int p = 0; p < NPH; ++p) {
        a.ph_lo = p; a.ph_hi = p + 1;
        hipLaunchKernelGGL(fwd_mega, dim3(grid), dim3(NWAVES * 64), LDS_BYTES, stream, a);
        const hipError_t le = hipPeekAtLastError();
        if (le != hipSuccess) { fprintf(stderr, "kernel_launch: launch %d failed: %s\n", p, hipGetErrorName(le)); break; }
    }
#endif
}
```

```cpp
#define ONE_LAUNCH 1
#define ATT1_SDEPTH 1
#define ATT0_SDEPTH 2
#define PROBE_MASK 0
#define ATT0_PX 1
#define GP_PROBE 0
#define PX_PROBE 0
#define PX_PROBE_BLOCK 0
#define PX_PROBE_WAVE 0
#define PX_PROBE_TILES 296.0
#define PROBE_DBL 0
#include <hip/hip_runtime.h>
#include <hip/hip_cooperative_groups.h>
#include <cstdio>
#include <cstdint>
namespace cg = cooperative_groups;
__device__ __forceinline__ int fresh_tid() { int t = threadIdx.x; asm volatile("" : "+v"(t)); return t & 511; }

#ifndef ONE_LAUNCH
#define ONE_LAUNCH 1
#endif

namespace pg8 {
#define PG8_LAS __attribute__((address_space(3)))
typedef unsigned short bf16_t;
typedef short bf16x8 __attribute__((ext_vector_type(8)));
typedef float f32x4 __attribute__((ext_vector_type(4)));
typedef unsigned u32x4 __attribute__((ext_vector_type(4)));
constexpr int BM = 256, BK = 64, HALF = 128, HTB = HALF * BK * 2  , STAGE_BYTES = 8 * HTB, NXCD = 8, WGM = 8;

__host__ __device__ __forceinline__ int lds_byte(int r, int c) { const int st = (r >> 4) * 2 + (c >> 5), rr = r & 15, cc = c & 31, ob = rr * 64 + cc * 2; return st * 1024 + (ob ^ (((ob >> 9) & 1) << 5)); }
__host__ __device__ __forceinline__ void stage_rc(int b, int& R, int& C) { const int st = b / 1024, sb = b % 1024, swz = sb ^ (((sb >> 9) & 1) << 5); R = (st >> 1) * 16 + swz / 64; C = (st & 1) * 32 + (swz % 64) / 2; }
__host__ __device__ __forceinline__ int perm32(int rho) { const int n = rho >> 4, i = rho & 15; return 8 * (i >> 2) + 4 * n + (i & 3); }

struct Unit { int pm, pn; };
struct Gemm { const bf16_t* A; const bf16_t* Bt; int M, N, K; };

struct StaticOrder {
    int nM, nN, nwg, G, c, lat;
    __host__ __device__ void init(int M, int N, int G_, int c_, int lat_only) { lat = lat_only; nM = lat_only ? (M / BM) / 9 * 8 : M / BM; nN = N / BM; nwg = nM * nN; G = G_; c = c_; }
    __host__ __device__ bool next(int i, Unit& u) const {
        const long L = (long)i * G + c; if (L >= nwg) return false;
        int wgid = (int)L; { const int q = nwg / NXCD, r = nwg % NXCD, xcd = wgid % NXCD, off = wgid / NXCD; wgid = (xcd < r ? xcd * (q + 1) : r * (q + 1) + (xcd - r) * q) + off; }
        const int nig = WGM * nN, gid = wgid / nig, fm = gid * WGM, gsz = (nM - fm) < WGM ? (nM - fm) : WGM;
        int pm = fm + ((wgid % nig) % gsz); u.pn = (wgid % nig) / gsz;
        if (lat) pm = (pm >> 3) * 9 + 1 + (pm & 7);
        u.pm = pm; return true;
    }
    __device__ __forceinline__ void a_ready(const Unit&) const {}
    __device__ __forceinline__ void done(const Unit&) const {}
};

__device__ __forceinline__ unsigned cvt_pk_bf16(float lo, float hi) { unsigned r; asm volatile("v_cvt_pk_bf16_f32 %0, %1, %2" : "=v"(r) : "v"(lo), "v"(hi)); return r; }

struct EpiBf16 {
    static constexpr bool PERM = true, AFTER_DRAIN = false;
    bf16_t* O; int ldc; const float* ss; const float* bias; int ldb;
    __device__ __forceinline__ void operator()(const f32x4 (&acc)[2][2][4][2], const Unit& u, int wr, int wc, int fr, int fq) const {
        const int row0 = u.pm * BM + wr * 64 + fr; const int col0 = u.pn * BM + wc * 32 + 8 * fq;
        const int b = u.pm / 9, r9 = u.pm - 9 * b; const float* bp = bias + (size_t)(r9 == 0 ? 8 : b) * ldb + col0;
#pragma unroll
        for (int ai = 0; ai < 2; ++ai)
#pragma unroll
            for (int m = 0; m < 4; ++m) { const int row = row0 + ai * HALF + m * 16; bf16_t* rowp = O + (size_t)row * ldc + col0;
                const float rs = ss ? __builtin_amdgcn_rsqf(ss[row] * (1.f / 2048.f) + 1e-6f) : 1.f;
#pragma unroll
                for (int bj = 0; bj < 2; ++bj) { f32x4 v0 = acc[ai][bj][m][0], v1 = acc[ai][bj][m][1];
                    if (ss) { v0 = v0 * rs + *(const f32x4*)(bp + bj * HALF); v1 = v1 * rs + *(const f32x4*)(bp + bj * HALF + 4); }
                    u32x4 w; w.x = cvt_pk_bf16(v0[0], v0[1]); w.y = cvt_pk_bf16(v0[2], v0[3]); w.z = cvt_pk_bf16(v1[0], v1[1]); w.w = cvt_pk_bf16(v1[2], v1[3]);
                    *(u32x4*)(rowp + bj * HALF) = w; } }
    }
};
struct EpiQKV {
    static constexpr bool PERM = true, AFTER_DRAIN = false;
    bf16_t* O; int ldc; const float* cs; const float* sn;
    __device__ __forceinline__ void operator()(const f32x4 (&acc)[2][2][4][2], const Unit& u, int wr, int wc, int fr, int fq) const {
        const int row0 = u.pm * BM + wr * 64 + fr; const int col0 = u.pn * BM + wc * 32 + 8 * fq;
        const int b = u.pm / 9, r9 = u.pm - 9 * b; const bool rot = r9 != 0 && u.pn < 16;
        const int t0 = (r9 - 1) * 256 + wr * 64 + fr; const int j0 = 16 * wc + 4 * fq;
#pragma unroll
        for (int ai = 0; ai < 2; ++ai)
#pragma unroll
            for (int m = 0; m < 4; ++m) { bf16_t* rowp = O + (size_t)(row0 + ai * HALF + m * 16) * ldc + col0;
                f32x4 c = {1.f, 1.f, 1.f, 1.f}, s = {0.f, 0.f, 0.f, 0.f};
                if (rot) { const int t = t0 + ai * HALF + m * 16; c = *(const f32x4*)(cs + t * 64 + j0); s = *(const f32x4*)(sn + t * 64 + j0); }
#pragma unroll
                for (int bj = 0; bj < 2; ++bj) { const f32x4 x1 = acc[ai][bj][m][0], x2 = acc[ai][bj][m][1];
                    const f32x4 v0 = x1 * c - x2 * s, v1 = x1 * s + x2 * c;
                    u32x4 w; w.x = cvt_pk_bf16(v0[0], v0[1]); w.y = cvt_pk_bf16(v0[2], v0[3]); w.z = cvt_pk_bf16(v1[0], v1[1]); w.w = cvt_pk_bf16(v1[2], v1[3]);
                    *(u32x4*)(rowp + bj * HALF) = w; } }
    }
};
struct EpiSwiGLU {
    static constexpr bool PERM = true, AFTER_DRAIN = false;
    bf16_t* O; int ldc; const float* ss; const float* bias;
    __device__ __forceinline__ float sg(float g, float u) const { return g * u * __builtin_amdgcn_rcpf(1.f + __builtin_amdgcn_exp2f(-1.4426950408889634f * g)); }
    __device__ __forceinline__ void operator()(const f32x4 (&acc)[2][2][4][2], const Unit& u, int wr, int wc, int fr, int fq) const {
        const int row0 = u.pm * BM + wr * 64 + fr; const int col0 = u.pn * HALF + wc * 32 + 8 * fq;
        const int b = u.pm / 9, r9 = u.pm - 9 * b; const float* bp = bias + (size_t)(r9 == 0 ? 8 : b) * 11264 + u.pn * BM + wc * 32 + 8 * fq;
        const f32x4 bg0 = *(const f32x4*)bp, bg1 = *(const f32x4*)(bp + 4), bu0 = *(const f32x4*)(bp + HALF), bu1 = *(const f32x4*)(bp + HALF + 4);
#pragma unroll
        for (int ai = 0; ai < 2; ++ai)
#pragma unroll
            for (int m = 0; m < 4; ++m) { const int row = row0 + ai * HALF + m * 16; bf16_t* rowp = O + (size_t)row * ldc + col0;
                const float rs = __builtin_amdgcn_rsqf(ss[row] * (1.f / 2048.f) + 1e-6f);
                const f32x4 g0 = acc[ai][0][m][0] * rs + bg0, g1 = acc[ai][0][m][1] * rs + bg1, u0 = acc[ai][1][m][0] * rs + bu0, u1 = acc[ai][1][m][1] * rs + bu1;
                u32x4 w; w.x = cvt_pk_bf16(sg(g0[0], u0[0]), sg(g0[1], u0[1])); w.y = cvt_pk_bf16(sg(g0[2], u0[2]), sg(g0[3], u0[3]));
                w.z = cvt_pk_bf16(sg(g1[0], u1[0]), sg(g1[1], u1[1])); w.w = cvt_pk_bf16(sg(g1[2], u1[2]), sg(g1[3], u1[3]));
                *(u32x4*)rowp = w; }
    }
};
struct EpiRes {
    static constexpr bool PERM = true, AFTER_DRAIN = false;
    float* X; const float* xin; const float* cin; const float* gate;
    bf16_t* H; const float* ng; const float* nscale; float* ss;
    __device__ __forceinline__ void operator()(const f32x4 (&acc)[2][2][4][2], const Unit& u, int wr, int wc, int fr, int fq) const {
        const int b = u.pm / 9, r9 = u.pm - 9 * b; const int brow = r9 == 0 ? 8 : b;
        const float* g = gate + (size_t)brow * 12288; const int col0 = u.pn * BM + wc * 32 + 8 * fq; const int rl = wr * 64 + fr;
        const float* res = xin ? (r9 == 0 ? cin + (size_t)b * 256 * 2048 : xin + ((size_t)b * 2048 + (size_t)(r9 - 1) * 256) * 2048) : X + (size_t)u.pm * BM * 2048;
        float* out = X + (size_t)u.pm * BM * 2048;
        f32x4 gv[2][2], wv[2][2];
#pragma unroll
        for (int bj = 0; bj < 2; ++bj)
#pragma unroll
            for (int n = 0; n < 2; ++n) { gv[bj][n] = *(const f32x4*)(g + col0 + bj * HALF + n * 4);
                if (H) wv[bj][n] = *(const f32x4*)(ng + col0 + bj * HALF + n * 4) * (*(const f32x4*)(nscale + (size_t)brow * 12288 + col0 + bj * HALF + n * 4) + 1.f); }
#pragma unroll
        for (int ai = 0; ai < 2; ++ai)
#pragma unroll
            for (int m = 0; m < 4; ++m) { const size_t off = (size_t)(rl + ai * HALF + m * 16) * 2048 + col0; float sq = 0.f;
#pragma unroll
                for (int bj = 0; bj < 2; ++bj) {
                    const f32x4 x0 = *(const f32x4*)(res + off + bj * HALF) + gv[bj][0] * acc[ai][bj][m][0], x1 = *(const f32x4*)(res + off + bj * HALF + 4) + gv[bj][1] * acc[ai][bj][m][1];
                    *(f32x4*)(out + off + bj * HALF) = x0; *(f32x4*)(out + off + bj * HALF + 4) = x1;
                    if (H) { const f32x4 h0 = x0 * wv[bj][0], h1 = x1 * wv[bj][1];
                        sq += ((x0[0] * x0[0] + x0[1] * x0[1]) + (x0[2] * x0[2] + x0[3] * x0[3])) + ((x1[0] * x1[0] + x1[1] * x1[1]) + (x1[2] * x1[2] + x1[3] * x1[3]));
                        u32x4 w; w.x = cvt_pk_bf16(h0[0], h0[1]); w.y = cvt_pk_bf16(h0[2], h0[3]); w.z = cvt_pk_bf16(h1[0], h1[1]); w.w = cvt_pk_bf16(h1[2], h1[3]);
                        *(u32x4*)(H + (size_t)u.pm * BM * 2048 + off + bj * HALF) = w; } }
                if (H) { sq += __shfl_xor(sq, 16); sq += __shfl_xor(sq, 32); if (fq == 0) unsafeAtomicAdd(ss + u.pm * BM + rl + ai * HALF + m * 16, sq); } }
    }
};

template <class Epi, class Sched, bool ALIGN_EPI = false, bool SP2 = false>
__device__ __forceinline__ void gemm_phase(PG8_LAS unsigned char* lds, const Gemm g, const Sched& S, const Epi& E) {
    const int tid = fresh_tid(), wid = __builtin_amdgcn_readfirstlane(tid >> 6), lane = tid & 63, wr = wid >> 2, wc = wid & 3, fr = lane & 15, fq = lane >> 4;
    const int K = g.K, nt = K / BK;
    unsigned voffA[2], voffB[2];
#pragma unroll
    for (int i = 0; i < 2; ++i) { int R, C; stage_rc(tid * 16 + i * 8192, R, C); const int Rb = Epi::PERM ? ((R & ~31) + perm32(R & 31)) : R;
        voffA[i] = (unsigned)(R * K + C) * 2u; voffB[i] = (unsigned)(Rb * K + C) * 2u; }
    const size_t kstep = (size_t)(BK * 2);
    const size_t hstep = (size_t)HALF * K * 2;
    const size_t tstep = 2 * hstep;
    const unsigned ldsw = (unsigned)wid * 1024u;
    const int aoff = lds_byte(wr * 64 + fr, fq * 8), boff = lds_byte(wc * 32 + fr, fq * 8);
#define PG8_SA(b, h) (((b) * 2 + (h)) * HTB)
#define PG8_SB(b, h) ((4 + (b) * 2 + (h)) * HTB)
#define PG8_STAGE(bufoff, gbase, voff) do { _Pragma("unroll") for (int _i = 0; _i < 2; ++_i) \
        __builtin_amdgcn_global_load_lds((const unsigned*)((const char*)(gbase) + (voff)[_i]), (PG8_LAS unsigned*)(lds + (bufoff) + ldsw + _i * 8192), 16, 0, 0); } while (0)
#define PG8_LDA(dst, b, h) do { _Pragma("unroll") for (int m = 0; m < 4; ++m) _Pragma("unroll") for (int k = 0; k < 2; ++k) dst[m][k] = *(const PG8_LAS bf16x8*)(lds + PG8_SA(b, h) + aoff + m * 2048 + k * 1024); } while (0)
#define PG8_LDB(dst, b, h) do { _Pragma("unroll") for (int n = 0; n < 2; ++n) _Pragma("unroll") for (int k = 0; k < 2; ++k) dst[n][k] = *(const PG8_LAS bf16x8*)(lds + PG8_SB(b, h) + boff + n * 2048 + k * 1024); } while (0)
#define PG8_MMA(ai, bj, At, Bt) do { __builtin_amdgcn_s_setprio(1); _Pragma("unroll") for (int m = 0; m < 4; ++m) _Pragma("unroll") for (int n = 0; n < 2; ++n) _Pragma("unroll") for (int k = 0; k < 2; ++k) \
        acc[ai][bj][m][n] = __builtin_amdgcn_mfma_f32_16x16x32_bf16(Bt[n][k], At[m][k], acc[ai][bj][m][n], 0, 0, 0); __builtin_amdgcn_s_setprio(0); } while (0)
#define PG8_WAIT_V(n) asm volatile("s_waitcnt vmcnt(" #n ")" ::: "memory")
#define PG8_WAIT_L(n) asm volatile("s_waitcnt lgkmcnt(" #n ")" ::: "memory")
#define PG8_BAR __builtin_amdgcn_s_barrier()
#define PG8_SCHED __builtin_amdgcn_sched_barrier(0)
    Unit cur, nxt; int ui = 0;
    if (!S.next(0, cur)) return;
    f32x4 acc[2][2][4][2];
#pragma unroll
    for (int a = 0; a < 2; ++a)
#pragma unroll
        for (int b = 0; b < 2; ++b)
#pragma unroll
            for (int m = 0; m < 4; ++m)
#pragma unroll
                for (int n = 0; n < 2; ++n) acc[a][b][m][n] = (f32x4){0.f, 0.f, 0.f, 0.f};
    bf16x8 At[4][2], B0[2][2], B1[2][2];
    const char* cA = (const char*)g.A + (size_t)cur.pm * tstep; const char* cB = (const char*)g.Bt + (size_t)cur.pn * tstep;
    S.a_ready(cur);
    if constexpr (SP2) {
        PG8_STAGE(PG8_SB(0, 0), cB, voffB); PG8_STAGE(PG8_SB(0, 1), cB + hstep, voffB); PG8_STAGE(PG8_SA(0, 0), cA, voffA); PG8_STAGE(PG8_SA(0, 1), cA + hstep, voffA);
        if (wr == 1) PG8_BAR;
        PG8_WAIT_V(2); PG8_BAR;
        PG8_STAGE(PG8_SB(1, 0), cB + kstep, voffB); PG8_STAGE(PG8_SA(1, 0), cA + kstep, voffA); PG8_STAGE(PG8_SB(1, 1), cB + hstep + kstep, voffB);
        PG8_WAIT_V(6); PG8_BAR;
    } else {
        PG8_STAGE(PG8_SB(0, 0), cB, voffB); PG8_STAGE(PG8_SA(0, 0), cA, voffA); PG8_STAGE(PG8_SB(0, 1), cB + hstep, voffB); PG8_STAGE(PG8_SA(0, 1), cA + hstep, voffA);
        if (wr == 1) PG8_BAR;
        PG8_WAIT_V(4); PG8_BAR;
        PG8_STAGE(PG8_SB(1, 0), cB + kstep, voffB); PG8_STAGE(PG8_SA(1, 0), cA + kstep, voffA); PG8_STAGE(PG8_SB(1, 1), cB + hstep + kstep, voffB);
        PG8_WAIT_V(6); PG8_BAR;
    }
    for (;;) {
        const bool has_next = S.next(ui + 1, nxt);
        const char* nA = has_next ? (const char*)g.A + (size_t)nxt.pm * tstep : cA; const char* nB = has_next ? (const char*)g.Bt + (size_t)nxt.pn * tstep : cB;
        for (int t = 0; t < nt; t += 2) {
            const bool last = (t == nt - 2);
            const char* a1 = cA + (size_t)(t + 1) * kstep;
            const char* a2 = last ? nA : cA + (size_t)(t + 2) * kstep; const char* b2 = last ? nB : cB + (size_t)(t + 2) * kstep;
            const char* a3 = a2 + kstep; const char* b3 = b2 + kstep;
            if (last && has_next) S.a_ready(nxt);
            if constexpr (SP2) {
            PG8_LDB(B0, 0, 0); PG8_LDB(B1, 0, 1); PG8_SCHED; PG8_LDA(At, 0, 0); PG8_STAGE(PG8_SA(1, 1), a1 + hstep, voffA);
            PG8_WAIT_V(8); PG8_WAIT_L(0); PG8_BAR; PG8_MMA(0, 0, At, B0); PG8_MMA(0, 1, At, B1); PG8_BAR; PG8_SCHED;
            PG8_LDA(At, 0, 1); PG8_STAGE(PG8_SB(0, 0), b2, voffB); PG8_STAGE(PG8_SB(0, 1), b2 + hstep, voffB); PG8_STAGE(PG8_SA(0, 0), a2, voffA);
            PG8_WAIT_V(8); PG8_WAIT_L(0); PG8_BAR; PG8_MMA(1, 0, At, B0); PG8_MMA(1, 1, At, B1); PG8_BAR; PG8_SCHED;
            PG8_LDB(B0, 1, 0); PG8_LDB(B1, 1, 1); PG8_SCHED; PG8_LDA(At, 1, 0); PG8_STAGE(PG8_SA(0, 1), a2 + hstep, voffA);
            PG8_WAIT_V(8); PG8_WAIT_L(0); PG8_BAR; PG8_MMA(0, 0, At, B0); PG8_MMA(0, 1, At, B1); PG8_BAR; PG8_SCHED;
            PG8_LDA(At, 1, 1); PG8_STAGE(PG8_SB(1, 0), b3, voffB); PG8_STAGE(PG8_SB(1, 1), b3 + hstep, voffB); PG8_STAGE(PG8_SA(1, 0), a3, voffA);
            PG8_WAIT_V(8); PG8_WAIT_L(0); PG8_BAR; PG8_MMA(1, 0, At, B0); PG8_MMA(1, 1, At, B1); PG8_BAR; PG8_SCHED;
            } else {
            PG8_LDB(B0, 0, 0); PG8_SCHED; PG8_LDA(At, 0, 0); PG8_STAGE(PG8_SA(1, 1), a1 + hstep, voffA);
            PG8_WAIT_L(8); PG8_BAR; PG8_WAIT_L(0); PG8_MMA(0, 0, At, B0); PG8_BAR; PG8_SCHED;
            PG8_LDB(B1, 0, 1); PG8_STAGE(PG8_SB(0, 0), b2, voffB);
            PG8_BAR; PG8_WAIT_L(0); PG8_MMA(0, 1, At, B1); PG8_BAR;
            PG8_LDA(At, 0, 1); PG8_STAGE(PG8_SA(0, 0), a2, voffA);
            PG8_BAR; PG8_WAIT_L(0); PG8_MMA(1, 0, At, B0); PG8_BAR; PG8_SCHED;
            PG8_STAGE(PG8_SB(0, 1), b2 + hstep, voffB);
            PG8_WAIT_V(6); PG8_BAR; PG8_MMA(1, 1, At, B1); PG8_BAR;
            PG8_LDB(B0, 1, 0); PG8_SCHED; PG8_LDA(At, 1, 0); PG8_STAGE(PG8_SA(0, 1), a2 + hstep, voffA);
            PG8_WAIT_L(8); PG8_BAR; PG8_WAIT_L(0); PG8_MMA(0, 0, At, B0); PG8_BAR; PG8_SCHED;
            PG8_LDB(B1, 1, 1); PG8_STAGE(PG8_SB(1, 0), b3, voffB);
            PG8_BAR; PG8_WAIT_L(0); PG8_MMA(0, 1, At, B1); PG8_BAR;
            PG8_LDA(At, 1, 1); PG8_STAGE(PG8_SA(1, 0), a3, voffA);
            PG8_BAR; PG8_WAIT_L(0); PG8_MMA(1, 0, At, B0); PG8_BAR; PG8_SCHED;
            PG8_STAGE(PG8_SB(1, 1), b3 + hstep, voffB);
            PG8_WAIT_V(6); PG8_BAR; PG8_MMA(1, 1, At, B1); PG8_BAR;
            }
        }
        if constexpr (ALIGN_EPI) { if (wr == 0) PG8_BAR; }
        if constexpr (!Epi::AFTER_DRAIN) { E(acc, cur, wr, wc, fr, fq); S.done(cur); }
        if (!has_next) break;
#pragma unroll
        for (int a = 0; a < 2; ++a)
#pragma unroll
            for (int b = 0; b < 2; ++b)
#pragma unroll
                for (int m = 0; m < 4; ++m)
#pragma unroll
                    for (int n = 0; n < 2; ++n) acc[a][b][m][n] = (f32x4){0.f, 0.f, 0.f, 0.f};
        cur = nxt; cA = nA; cB = nB; ++ui;
        if constexpr (ALIGN_EPI) { if (wr == 1) PG8_BAR; }
    }
    PG8_WAIT_V(0);
    if constexpr (!ALIGN_EPI) { if (wr == 0) PG8_BAR; }
    PG8_BAR;
    if constexpr (Epi::AFTER_DRAIN) { E.fused(acc, cur, wr, wc, fr, fq, lds, wid, lane); S.done(cur); }
#undef PG8_SA
#undef PG8_SB
#undef PG8_STAGE
#undef PG8_LDA
#undef PG8_LDB
#undef PG8_MMA
#undef PG8_WAIT_V
#undef PG8_WAIT_L
#undef PG8_BAR
#undef PG8_SCHED
}
}

namespace att {
typedef unsigned short bf16_t;
using bf16x8 = __attribute__((ext_vector_type(8))) short;
using s16x4  = __attribute__((ext_vector_type(4))) short;
using f32x16 = __attribute__((ext_vector_type(16))) float;
using f32x4  = __attribute__((ext_vector_type(4))) float;
using u32x4  = __attribute__((ext_vector_type(4))) unsigned;
constexpr int NW = 8, QBLK = 32, KVBLK = 64;
constexpr float THR = 8.f;
constexpr int SHM_V = KVBLK * 128 * 2, SHM_K = KVBLK * 128 * 2, SHM_KR = KVBLK * 64 * 2;
constexpr int OFF_V = 0, OFF_K = 2 * SHM_V, OFF_KR = OFF_K + 2 * SHM_K, OFF_WS = OFF_KR + 2 * SHM_KR, OFF_QR = OFF_WS + NW * 64 * 4, ATT_LDS = OFF_QR + NW * 4096;
#define KSWZ(row, colB) ((row) * 256 + ((colB) ^ (((row) & 15) << 4)))
#define KRSWZ(row, colB) ((row) * 128 + ((colB) ^ ((((row) >> 1) & 7) << 4)))
#define SBAR() __builtin_amdgcn_sched_barrier(0)
__device__ __forceinline__ int crow(int r, int hi) { return (r & 3) + 8 * (r >> 2) + 4 * hi; }
__device__ __forceinline__ unsigned cvtpk(float lo, float hi) { unsigned r; asm volatile("v_cvt_pk_bf16_f32 %0, %1, %2" : "=v"(r) : "v"(lo), "v"(hi)); return r; }
__device__ __forceinline__ float bf2f(short s) { return __uint_as_float(((unsigned)(unsigned short)s) << 16); }

template <int DQK> struct SC { static constexpr float SCALE = DQK == 192 ? 0.07216878364870322f : 0.08838834764831845f; };

template <int DQK>
__device__ __forceinline__ void partialSM(f32x16& p0, f32x16& p1, float& m_reg, float& mn, float& alpha) {
  constexpr float SCALE = SC<DQK>::SCALE; constexpr float C = SCALE * 1.4426950408889634f;
  float pmax = p0[0]; for (int r = 1; r < 16; ++r) pmax = fmaxf(pmax, p0[r]); for (int r = 0; r < 16; ++r) pmax = fmaxf(pmax, p1[r]);
  { auto rr = __builtin_amdgcn_permlane32_swap(__float_as_uint(pmax), __float_as_uint(pmax), false, false);
    pmax = fmaxf(__uint_as_float(rr[0]), __uint_as_float(rr[1])); }
  if (__builtin_expect(__all(pmax - m_reg <= THR / SCALE), 1)) { mn = m_reg; alpha = 1.f; }
  else { mn = fmaxf(m_reg, pmax); alpha = __builtin_amdgcn_exp2f((m_reg - mn) * C); m_reg = mn; }
  float mnC = -mn * C;
  for (int r = 0; r < 16; ++r) p0[r] = fmaf(p0[r], C, mnC); for (int r = 0; r < 16; ++r) p1[r] = fmaf(p1[r], C, mnC);
  for (int r = 0; r < 16; ++r) p0[r] = __builtin_amdgcn_exp2f(p0[r]);
}
__device__ __forceinline__ void finishSM(f32x16& p0, f32x16& p1, float alpha, float& l_reg, bf16x8& pa0, bf16x8& pa1, bf16x8& pa2, bf16x8& pa3) {
  for (int r = 0; r < 16; ++r) p1[r] = __builtin_amdgcn_exp2f(p1[r]);
  float ps = 0; for (int r = 0; r < 16; ++r) ps += p0[r]; for (int r = 0; r < 16; ++r) ps += p1[r];
  { auto rr = __builtin_amdgcn_permlane32_swap(__float_as_uint(ps), __float_as_uint(ps), false, false);
    ps = __uint_as_float(rr[0]) + __uint_as_float(rr[1]); }
  l_reg = l_reg * alpha + ps;
#define PK4(P, BASE, OUT) do { unsigned a0 = cvtpk(P[BASE + 0], P[BASE + 1]), a1 = cvtpk(P[BASE + 2], P[BASE + 3]);   \
    unsigned b0 = cvtpk(P[BASE + 4], P[BASE + 5]), b1 = cvtpk(P[BASE + 6], P[BASE + 7]);                              \
    auto r0 = __builtin_amdgcn_permlane32_swap(a0, b0, false, false); auto r1 = __builtin_amdgcn_permlane32_swap(a1, b1, false, false); \
    u32x4 w = {r0[0], r1[0], r0[1], r1[1]}; OUT = *reinterpret_cast<bf16x8*>(&w); } while (0)
  PK4(p0, 0, pa0); PK4(p0, 8, pa1); PK4(p1, 0, pa2); PK4(p1, 8, pa3);
#undef PK4
}
template <int DQK>
__device__ __forceinline__ void qkt(f32x16& p0, f32x16& p1, const char* Ks, const char* KRs, const bf16x8* qr, const char* qrl, int r32, int hi) {
  p0 = f32x16{}; p1 = f32x16{};
#pragma unroll
  for (int d0 = 0; d0 < 8; ++d0) { int cb = (d0 * 16 + hi * 8) * 2;
    bf16x8 b0 = *reinterpret_cast<const bf16x8*>(Ks + KSWZ(r32, cb));
    bf16x8 b1 = *reinterpret_cast<const bf16x8*>(Ks + KSWZ(32 + r32, cb));
    p0 = __builtin_amdgcn_mfma_f32_32x32x16_bf16(b0, qr[d0], p0, 0, 0, 0);
    p1 = __builtin_amdgcn_mfma_f32_32x32x16_bf16(b1, qr[d0], p1, 0, 0, 0); }
  if constexpr (DQK == 192) {
#pragma unroll
    for (int d0 = 0; d0 < 4; ++d0) { int cb = (d0 * 16 + hi * 8) * 2;
      bf16x8 b0 = *reinterpret_cast<const bf16x8*>(KRs + KRSWZ(r32, cb));
      bf16x8 b1 = *reinterpret_cast<const bf16x8*>(KRs + KRSWZ(32 + r32, cb));
      const bf16x8 qx = *reinterpret_cast<const bf16x8*>(qrl + d0 * 1024);
      p0 = __builtin_amdgcn_mfma_f32_32x32x16_bf16(b0, qx, p0, 0, 0, 0);
      p1 = __builtin_amdgcn_mfma_f32_32x32x16_bf16(b1, qx, p1, 0, 0, 0); }
  }
}
__device__ __forceinline__ int v_st(int k, int c) { const int kk = (k & ~0xC) | ((k & 4) << 1) | ((k & 8) >> 1); return ((kk >> 3) * 4 + (c >> 5)) * 512 + ((kk & 7) * 32 + (c & 31)) * 2; }
__device__ __forceinline__ int v_rd_base(int lane) { return ((lane & 3) << 3) | (((lane >> 2) & 3) << 6) | (((lane >> 4) & 1) << 5) | (((lane >> 5) & 1) << 8); }
constexpr int v_rd_off(int d0, int ks, int half) { return d0 * 512 + ks * 4096 + half * 2048; }
template <int OFF> __device__ __forceinline__ s16x4 tr_read(int vb) {
  s16x4 r; asm volatile("ds_read_b64_tr_b16 %0, %1 offset:%2" : "=&v"(r) : "v"(vb), "i"(OFF) : "memory"); return r;
}
template <int D0> __device__ __forceinline__ void pv_one(f32x16& od, int vb, bf16x8 pa0, bf16x8 pa1, bf16x8 pa2, bf16x8 pa3) {
  const s16x4 l0 = tr_read<v_rd_off(D0, 0, 0)>(vb), h0 = tr_read<v_rd_off(D0, 0, 1)>(vb), l1 = tr_read<v_rd_off(D0, 1, 0)>(vb), h1 = tr_read<v_rd_off(D0, 1, 1)>(vb);
  const s16x4 l2 = tr_read<v_rd_off(D0, 2, 0)>(vb), h2 = tr_read<v_rd_off(D0, 2, 1)>(vb), l3 = tr_read<v_rd_off(D0, 3, 0)>(vb), h3 = tr_read<v_rd_off(D0, 3, 1)>(vb);
  asm volatile("s_waitcnt lgkmcnt(0)" ::: "memory"); SBAR();
#define PK(L, H) (bf16x8){L[0], L[1], L[2], L[3], H[0], H[1], H[2], H[3]}
  od = __builtin_amdgcn_mfma_f32_32x32x16_bf16(pa0, PK(l0, h0), od, 0, 0, 0);
  od = __builtin_amdgcn_mfma_f32_32x32x16_bf16(pa1, PK(l1, h1), od, 0, 0, 0);
  od = __builtin_amdgcn_mfma_f32_32x32x16_bf16(pa2, PK(l2, h2), od, 0, 0, 0);
  od = __builtin_amdgcn_mfma_f32_32x32x16_bf16(pa3, PK(l3, h3), od, 0, 0, 0);
#undef PK
}
__device__ __forceinline__ void pv_d0(f32x16* o, int vb, bf16x8 pa0, bf16x8 pa1, bf16x8 pa2, bf16x8 pa3) {
  pv_one<0>(o[0], vb, pa0, pa1, pa2, pa3); pv_one<1>(o[1], vb, pa0, pa1, pa2, pa3); pv_one<2>(o[2], vb, pa0, pa1, pa2, pa3); pv_one<3>(o[3], vb, pa0, pa1, pa2, pa3);
}

template <int DQK, int SDEPTH, int ldq, int ldk, int ldv, int ldo>
__device__ __forceinline__ void attn_body(const bf16_t* __restrict__ Qb, const bf16_t* __restrict__ Kh, const bf16_t* __restrict__ KRh,
                                          const bf16_t* __restrict__ Vh, bf16_t* __restrict__ Ob, int seq,
                                          const float* __restrict__ cs, const float* __restrict__ sn, char* lds) {
  constexpr bool ROPE = DQK == 192; constexpr int ND0 = DQK / 16;
  const int tid = fresh_tid(), wid = tid >> 6, lane = tid & 63, r32 = lane & 31, hi = lane >> 5;
  char* V_lds = lds + OFF_V; char* K_lds = lds + OFF_K; char* KR_lds = lds + OFF_KR;
  float* ws = (float*)(lds + OFF_WS) + wid * 64; float* li_l = ws; float* al_l = ws + 32;
  float m_reg = -1e30f, l_reg = 0; f32x16 o[4] = {}; bf16x8 qr[8];
  char* qrl = lds + OFF_QR + wid * 4096 + lane * 16;
  __syncthreads();
  const bf16_t* Qw = Qb + (size_t)(wid * QBLK + r32) * ldq + hi * 8;
#pragma unroll
  for (int d0 = 0; d0 < 8; ++d0) qr[d0] = *reinterpret_cast<const bf16x8*>(Qw + d0 * 16);
  if constexpr (ROPE) {
    bf16x8 qx[4];
#pragma unroll
    for (int d0 = 0; d0 < 4; ++d0) qx[d0] = *reinterpret_cast<const bf16x8*>(Qw + 128 + d0 * 16);
    if (cs) {
      const float* cr = cs + (size_t)(wid * QBLK + r32) * 32 + hi * 8; const float* sr2 = sn + (size_t)(wid * QBLK + r32) * 32 + hi * 8;
#pragma unroll
      for (int p = 0; p < 2; ++p) {
        const f32x4 c0 = *(const f32x4*)(cr + p * 16), c1 = *(const f32x4*)(cr + p * 16 + 4), s0 = *(const f32x4*)(sr2 + p * 16), s1 = *(const f32x4*)(sr2 + p * 16 + 4);
        float x1[8], x2[8], y1[8], y2[8];
#pragma unroll
        for (int e = 0; e < 8; ++e) { x1[e] = bf2f(qx[p][e]); x2[e] = bf2f(qx[2 + p][e]); }
#pragma unroll
        for (int e = 0; e < 8; ++e) { const float c = e < 4 ? c0[e & 3] : c1[e & 3], s = e < 4 ? s0[e & 3] : s1[e & 3]; y1[e] = x1[e] * c - x2[e] * s; y2[e] = x1[e] * s + x2[e] * c; }
        u32x4 w1 = {cvtpk(y1[0], y1[1]), cvtpk(y1[2], y1[3]), cvtpk(y1[4], y1[5]), cvtpk(y1[6], y1[7])};
        u32x4 w2 = {cvtpk(y2[0], y2[1]), cvtpk(y2[2], y2[3]), cvtpk(y2[4], y2[5]), cvtpk(y2[6], y2[7])};
        qx[p] = *reinterpret_cast<bf16x8*>(&w1); qx[2 + p] = *reinterpret_cast<bf16x8*>(&w2);
      }
    }
#pragma unroll
    for (int d0 = 0; d0 < 4; ++d0) *reinterpret_cast<bf16x8*>(qrl + d0 * 1024) = qx[d0];
  }
  const int sr = tid >> 4, sc = (tid & 15) * 8, vst0 = v_st(sr, sc), vst1 = v_st(32 + sr, sc);
  const int krr = tid >> 3, krc = (tid & 7) * 8;
  const int vb0 = (int)(uintptr_t)V_lds + v_rd_base(lane);
  struct { bf16x8 vs0, vs1, ks0, ks1, kr; } sr_[SDEPTH];
#define SLOAD(i, k0) do { sr_[i].vs0 = *(const bf16x8*)(&Vh[(size_t)((k0) + sr) * ldv + sc]); sr_[i].vs1 = *(const bf16x8*)(&Vh[(size_t)((k0) + 32 + sr) * ldv + sc]); \
    sr_[i].ks0 = *(const bf16x8*)(&Kh[(size_t)((k0) + sr) * ldk + sc]); sr_[i].ks1 = *(const bf16x8*)(&Kh[(size_t)((k0) + 32 + sr) * ldk + sc]); \
    if constexpr (ROPE) sr_[i].kr = *(const bf16x8*)(&KRh[(size_t)((k0) + krr) * 64 + krc]); } while (0)
#define SWRITE(b, i) do { *(bf16x8*)(V_lds + (b) * SHM_V + vst0) = sr_[i].vs0;          \
    *(bf16x8*)(V_lds + (b) * SHM_V + vst1) = sr_[i].vs1; int kc = sc * 2;               \
    *(bf16x8*)(K_lds + (b) * SHM_K + KSWZ(sr, kc)) = sr_[i].ks0;                       \
    *(bf16x8*)(K_lds + (b) * SHM_K + KSWZ(32 + sr, kc)) = sr_[i].ks1;                  \
    if constexpr (ROPE) *(bf16x8*)(KR_lds + (b) * SHM_KR + KRSWZ(krr, krc * 2)) = sr_[i].kr; } while (0)
#define SWAIT() do { if constexpr (SDEPTH == 2) { if constexpr (ROPE) asm volatile("s_waitcnt vmcnt(5)" ::: "memory"); else asm volatile("s_waitcnt vmcnt(4)" ::: "memory"); } \
    else asm volatile("s_waitcnt vmcnt(0)" ::: "memory"); } while (0)
#define RESC(a) do { if (__any((a) < 1.f)) { if (hi == 0) al_l[r32] = (a); asm volatile("s_waitcnt lgkmcnt(0)" ::: "memory"); \
    for (int d = 0; d < 4; ++d) for (int r = 0; r < 16; ++r) o[d][r] *= al_l[crow(r, hi)]; } } while (0)
  f32x16 pA0, pA1, pB0, pB1; float mnA, mnB, alA, alB; bf16x8 pa0, pa1, pa2, pa3; const int NT = seq / KVBLK;
  constexpr int SE = 0, SO = SDEPTH - 1;
  SLOAD(SE, 0); asm volatile("s_waitcnt vmcnt(0)" ::: "memory"); SWRITE(0, SE); __syncthreads();
  qkt<DQK>(pA0, pA1, K_lds, KR_lds, qr, qrl, r32, hi); partialSM<DQK>(pA0, pA1, m_reg, mnA, alA);
  SLOAD(SO, KVBLK); if constexpr (SDEPTH == 2) { if (2 < NT) SLOAD(SE, 2 * KVBLK); }
  SWAIT(); SWRITE(1, SO); __syncthreads();
  for (int j = 1; j + 1 < NT; j += 2) {
    SBAR(); qkt<DQK>(pB0, pB1, K_lds + SHM_K, KR_lds + SHM_KR, qr, qrl, r32, hi);
    finishSM(pA0, pA1, alA, l_reg, pa0, pa1, pa2, pa3); SBAR();
    SLOAD(SO, (j + SDEPTH) * KVBLK); SBAR();
    pv_d0(o, vb0, pa0, pa1, pa2, pa3); partialSM<DQK>(pB0, pB1, m_reg, mnB, alB);
    __syncthreads(); SWAIT(); SWRITE(0, SE);
    RESC(alB); __syncthreads();
    SBAR(); qkt<DQK>(pA0, pA1, K_lds, KR_lds, qr, qrl, r32, hi);
    finishSM(pB0, pB1, alB, l_reg, pa0, pa1, pa2, pa3); SBAR();
    if (SDEPTH == 1 || j + 3 < NT) SLOAD(SE, (j + 1 + SDEPTH) * KVBLK); SBAR();
    pv_d0(o, vb0 + (int)SHM_V, pa0, pa1, pa2, pa3); partialSM<DQK>(pA0, pA1, m_reg, mnA, alA);
    __syncthreads(); SWAIT(); SWRITE(1, SO);
    RESC(alA); __syncthreads();
  }
  SBAR(); qkt<DQK>(pB0, pB1, K_lds + SHM_K, KR_lds + SHM_KR, qr, qrl, r32, hi);
  finishSM(pA0, pA1, alA, l_reg, pa0, pa1, pa2, pa3); SBAR();
  pv_d0(o, vb0, pa0, pa1, pa2, pa3); partialSM<DQK>(pB0, pB1, m_reg, mnB, alB);
  __syncthreads(); RESC(alB);
  finishSM(pB0, pB1, alB, l_reg, pa0, pa1, pa2, pa3); SBAR();
  pv_d0(o, vb0 + (int)SHM_V, pa0, pa1, pa2, pa3);
  if (hi == 0) li_l[r32] = l_reg; asm volatile("s_waitcnt lgkmcnt(0)" ::: "memory");
  __syncthreads();
  char* Wl = lds + wid * 8192 + hi * 1024 + r32 * 2;
#pragma unroll
  for (int r = 0; r < 16; r += 2) {
    const float ra = __builtin_amdgcn_rcpf(li_l[crow(r, hi)]), rb = __builtin_amdgcn_rcpf(li_l[crow(r + 1, hi)]);
#pragma unroll
    for (int d0 = 0; d0 < 4; ++d0) {
      const unsigned w = cvtpk(o[d0][r] * ra, o[d0][r + 1] * rb);
      *(unsigned short*)(Wl + crow(r, 0) * 256 + d0 * 64) = (unsigned short)(w & 0xffffu);
      *(unsigned short*)(Wl + crow(r + 1, 0) * 256 + d0 * 64) = (unsigned short)(w >> 16);
    }
    SBAR();
  }
  asm volatile("s_waitcnt lgkmcnt(0)" ::: "memory");
  bf16_t* Ow = Ob + (size_t)(wid * QBLK) * ldo;
#pragma unroll
  for (int i = 0; i < 8; ++i) { const int ch = i * 64 + lane, row = ch >> 4, c16 = ch & 15;
    const u32x4 v = *(const u32x4*)(lds + wid * 8192 + row * 256 + c16 * 16);
    *(u32x4*)(Ow + (size_t)row * ldo + c16 * 8) = v; }
#undef SLOAD
#undef SWRITE
#undef SWAIT
#undef RESC
}

struct VFrag { s16x4 l0, h0, l1, h1, l2, h2, l3, h3; };
template <int KS> __device__ __forceinline__ VFrag v_frag(int vb) {
  VFrag f; f.l0 = tr_read<v_rd_off(0, KS, 0)>(vb); f.h0 = tr_read<v_rd_off(0, KS, 1)>(vb); f.l1 = tr_read<v_rd_off(1, KS, 0)>(vb); f.h1 = tr_read<v_rd_off(1, KS, 1)>(vb);
  f.l2 = tr_read<v_rd_off(2, KS, 0)>(vb); f.h2 = tr_read<v_rd_off(2, KS, 1)>(vb); f.l3 = tr_read<v_rd_off(3, KS, 0)>(vb); f.h3 = tr_read<v_rd_off(3, KS, 1)>(vb); return f;
}
#define PKV(L, H) (bf16x8){L[0], L[1], L[2], L[3], H[0], H[1], H[2], H[3]}
__device__ __forceinline__ void pv_step(f32x16* o, bf16x8 pa, const VFrag& f) {
  o[0] = __builtin_amdgcn_mfma_f32_32x32x16_bf16(pa, PKV(f.l0, f.h0), o[0], 0, 0, 0);
  o[1] = __builtin_amdgcn_mfma_f32_32x32x16_bf16(pa, PKV(f.l1, f.h1), o[1], 0, 0, 0);
  o[2] = __builtin_amdgcn_mfma_f32_32x32x16_bf16(pa, PKV(f.l2, f.h2), o[2], 0, 0, 0);
  o[3] = __builtin_amdgcn_mfma_f32_32x32x16_bf16(pa, PKV(f.l3, f.h3), o[3], 0, 0, 0);
}
__device__ __forceinline__ void pv_d0_pf(f32x16* o, int vb, bf16x8 pa0, bf16x8 pa1, bf16x8 pa2, bf16x8 pa3) {
  VFrag a = v_frag<0>(vb); VFrag b = v_frag<1>(vb);
  asm volatile("s_waitcnt lgkmcnt(8)" ::: "memory"); SBAR(); pv_step(o, pa0, a); SBAR();
  a = v_frag<2>(vb);
  asm volatile("s_waitcnt lgkmcnt(8)" ::: "memory"); SBAR(); pv_step(o, pa1, b); SBAR();
  b = v_frag<3>(vb);
  asm volatile("s_waitcnt lgkmcnt(8)" ::: "memory"); SBAR(); pv_step(o, pa2, a); SBAR();
  asm volatile("s_waitcnt lgkmcnt(0)" ::: "memory"); SBAR(); pv_step(o, pa3, b); SBAR();
}
#undef PKV

constexpr int PX_V = 0, PX_K = 65536, PX_X1 = PX_K + 3 * 16384, PX_PS = PX_X1 + 2048, PX_X2 = PX_PS + 1024, PX_WS = PX_X2 + 16384, PX_END = PX_WS + 2048;
static_assert(PX_END <= 147456 - 16, "pair-exchange LDS map");
__device__ __forceinline__ void px_pass(const bf16_t* __restrict__ Qb, const bf16_t* __restrict__ Kh, const bf16_t* __restrict__ Vh, int seq, char* lds, f32x16 (&o)[4], float& l_out) {
  constexpr int LD = 6144; constexpr float SCALE = 0.08838834764831845f, C = SCALE * 1.4426950408889634f;
  const int tid = fresh_tid(), wid = tid >> 6, lane = tid & 63, r32 = lane & 31, hi = lane >> 5, grp = wid & 3, role = wid >> 2, pw = wid ^ 4;
  float* X1 = (float*)(lds + PX_X1); float* PS = (float*)(lds + PX_PS); char* X2 = lds + PX_X2;
  float* al_l = (float*)(lds + PX_WS) + wid * 64;
  float l_reg = 0.f;
  float m_reg = -1e30f; bf16x8 qr[8];
#pragma unroll
  for (int d = 0; d < 4; ++d) o[d] = f32x16{};
  __syncthreads();
  const bf16_t* Qw = Qb + (size_t)(grp * 32 + r32) * LD + hi * 8;
#pragma unroll
  for (int d0 = 0; d0 < 8; ++d0) qr[d0] = *reinterpret_cast<const bf16x8*>(Qw + d0 * 16);
  const int sr = tid >> 4, sc = (tid & 15) * 8, vr = tid >> 3, vc = tid & 7;
  bf16x8 ks0, ks1, vv[4];
#define PX_KLOAD(k0) do { ks0 = *(const bf16x8*)(&Kh[(size_t)((k0) + sr) * LD + sc]); ks1 = *(const bf16x8*)(&Kh[(size_t)((k0) + 32 + sr) * LD + sc]); } while (0)
#define PX_VLOAD(k0) do { _Pragma("unroll") for (int i = 0; i < 4; ++i) vv[i] = *(const bf16x8*)(&Vh[(size_t)((k0) + vr) * LD + (vc + 8 * i) * 8]); } while (0)
#define PX_KWRITE(slot) do { *(bf16x8*)(lds + PX_K + (slot) * 16384 + KSWZ(sr, sc * 2)) = ks0; *(bf16x8*)(lds + PX_K + (slot) * 16384 + KSWZ(32 + sr, sc * 2)) = ks1; } while (0)
#define PX_VWRITE(slot) do { _Pragma("unroll") for (int i = 0; i < 4; ++i) { const int col = (vc + 8 * i) * 8; *(bf16x8*)(lds + PX_V + (slot) * 32768 + (col >> 7) * 16384 + v_st(vr, col & 127)) = vv[i]; } } while (0)
#define PX_QK(P, PMAX, slot) do { const char* Ks_ = lds + PX_K + (slot) * 16384; P = f32x16{}; \
    _Pragma("unroll") for (int d0 = 0; d0 < 8; ++d0) { const bf16x8 kb = *reinterpret_cast<const bf16x8*>(Ks_ + KSWZ(role * 32 + r32, (d0 * 16 + hi * 8) * 2)); \
      P = __builtin_amdgcn_mfma_f32_32x32x16_bf16(kb, qr[d0], P, 0, 0, 0); } \
    PMAX = P[0]; _Pragma("unroll") for (int r = 1; r < 16; ++r) PMAX = fmaxf(PMAX, P[r]); \
    { auto rr = __builtin_amdgcn_permlane32_swap(__float_as_uint(PMAX), __float_as_uint(PMAX), false, false); PMAX = fmaxf(__uint_as_float(rr[0]), __uint_as_float(rr[1])); } } while (0)
  const int NT = seq / KVBLK;
  const int vbase = (int)(uintptr_t)(lds + PX_V) + role * 16384 + v_rd_base(lane);
  f32x16 pn; float pmaxn;
  PX_KLOAD(0); PX_VLOAD(0); PX_KWRITE(0); PX_VWRITE(0); if (1 < NT) PX_KLOAD(KVBLK);
  __syncthreads();
  PX_QK(pn, pmaxn, 0); if (hi == 0) X1[wid * 32 + r32] = pmaxn;
  if (1 < NT) { PX_KWRITE(1); PX_VLOAD(KVBLK); } if (2 < NT) PX_KLOAD(2 * KVBLK);
  __syncthreads();
  int kslot = 1;
  for (int t = 0; t < NT; ++t) {
    f32x16 p = pn; float pmax = fmaxf(pmaxn, X1[(t & 1) * 256 + pw * 32 + r32]);
    if (t + 1 < NT) { PX_QK(pn, pmaxn, kslot); if (hi == 0) X1[((t + 1) & 1) * 256 + wid * 32 + r32] = pmaxn; }
    float mn, alpha;
    if (__builtin_expect(__all(pmax - m_reg <= THR / SCALE), 1)) { mn = m_reg; alpha = 1.f; }
    else { mn = fmaxf(m_reg, pmax); alpha = __builtin_amdgcn_exp2f((m_reg - mn) * C); m_reg = mn; }
    const float mnC = -mn * C; float ps = 0.f;
#pragma unroll
    for (int r = 0; r < 16; ++r) { p[r] = __builtin_amdgcn_exp2f(fmaf(p[r], C, mnC)); ps += p[r]; }
    { auto rr = __builtin_amdgcn_permlane32_swap(__float_as_uint(ps), __float_as_uint(ps), false, false); ps = __uint_as_float(rr[0]) + __uint_as_float(rr[1]); }
    bf16x8 fa, fb;
#define PK4(P, BASE, OUT) do { unsigned a0 = cvtpk(P[BASE + 0], P[BASE + 1]), a1 = cvtpk(P[BASE + 2], P[BASE + 3]);   \
    unsigned b0 = cvtpk(P[BASE + 4], P[BASE + 5]), b1 = cvtpk(P[BASE + 6], P[BASE + 7]);                              \
    auto r0 = __builtin_amdgcn_permlane32_swap(a0, b0, false, false); auto r1 = __builtin_amdgcn_permlane32_swap(a1, b1, false, false); \
    u32x4 w = {r0[0], r1[0], r0[1], r1[1]}; OUT = *reinterpret_cast<bf16x8*>(&w); } while (0)
    PK4(p, 0, fa); PK4(p, 8, fb);
#undef PK4
    *(bf16x8*)(X2 + (wid * 64 + lane) * 32) = fa; *(bf16x8*)(X2 + (wid * 64 + lane) * 32 + 16) = fb;
    if (hi == 0) PS[wid * 32 + r32] = ps;
    if (__any(alpha < 1.f)) { if (hi == 0) al_l[r32] = alpha; asm volatile("s_waitcnt lgkmcnt(0)" ::: "memory");
#pragma unroll
      for (int d = 0; d < 4; ++d)
#pragma unroll
        for (int r = 0; r < 16; ++r) o[d][r] *= al_l[crow(r, hi)]; }
    if (t + 1 < NT) { PX_VWRITE((t + 1) & 1); if (t + 2 < NT) PX_VLOAD((t + 2) * KVBLK); }
    __syncthreads();
    const int w0 = wid & 3;
    const bf16x8 pa0 = *(const bf16x8*)(X2 + (w0 * 64 + lane) * 32), pa1 = *(const bf16x8*)(X2 + (w0 * 64 + lane) * 32 + 16);
    const bf16x8 pa2 = *(const bf16x8*)(X2 + ((w0 + 4) * 64 + lane) * 32), pa3 = *(const bf16x8*)(X2 + ((w0 + 4) * 64 + lane) * 32 + 16);
    l_reg = l_reg * alpha + (PS[w0 * 32 + r32] + PS[(w0 + 4) * 32 + r32]);
    asm volatile("s_waitcnt lgkmcnt(0)" ::: "memory"); SBAR();
    pv_d0_pf(o, vbase + (t & 1) * 32768, pa0, pa1, pa2, pa3);
    kslot = kslot == 2 ? 0 : kslot + 1;
    if (t + 2 < NT) { PX_KWRITE(kslot); if (t + 3 < NT) PX_KLOAD((t + 3) * KVBLK); }
    __syncthreads();
  }
  l_out = l_reg;
#undef PX_KLOAD
#undef PX_VLOAD
#undef PX_KWRITE
#undef PX_VWRITE
#undef PX_QK
}
__device__ __forceinline__ void attn_px_body(const bf16_t* __restrict__ Qb0, const bf16_t* __restrict__ Kh0, const bf16_t* __restrict__ Vh, bf16_t* __restrict__ Ob, int seq, float lam_u, const float* __restrict__ sg, unsigned* __restrict__ park, char* lds) {
  constexpr int LDO = 2048;
  f32x16 o[4]; float l_reg = 0.f;
  px_pass(Qb0, Kh0, Vh, seq, lds, o, l_reg);
  {
    const int tid = fresh_tid(), wid = tid >> 6, lane = tid & 63, r32 = lane & 31, hi = lane >> 5;
    float* li_l = (float*)(lds + PX_WS) + wid * 64 + 32; unsigned* pk = park + wid * 64 + lane;
    if (hi == 0) li_l[r32] = l_reg; asm volatile("s_waitcnt lgkmcnt(0)" ::: "memory");
#pragma unroll
    for (int r = 0; r < 16; r += 2) { const float ra = __builtin_amdgcn_rcpf(li_l[crow(r, hi)]), rb = __builtin_amdgcn_rcpf(li_l[crow(r + 1, hi)]);
#pragma unroll
      for (int d = 0; d < 4; ++d) pk[(d * 8 + (r >> 1)) * 512] = cvtpk(o[d][r] * ra, o[d][r + 1] * rb); }
  }
  px_pass(Qb0 + 128, Kh0 + 128, Vh, seq, lds, o, l_reg);
  const int tid = fresh_tid(), wid = tid >> 6, lane = tid & 63, r32 = lane & 31, hi = lane >> 5, grp = wid & 3, role = wid >> 2, pw = wid ^ 4;
  float* li_l = (float*)(lds + PX_WS) + wid * 64 + 32; unsigned* pk = park + wid * 64 + lane;
  const float lam = __uint_as_float(__builtin_amdgcn_readfirstlane(__float_as_uint(lam_u)));
  if (hi == 0) li_l[r32] = l_reg; asm volatile("s_waitcnt lgkmcnt(0)" ::: "memory");
  float gsc[4];
#pragma unroll
  for (int d = 0; d < 4; ++d) gsc[d] = sg[role * 128 + d * 32 + r32] * 0.8f;
  float sq[16];
#pragma unroll
  for (int r = 0; r < 16; r += 2) { const float ra = __builtin_amdgcn_rcpf(li_l[crow(r, hi)]), rb = __builtin_amdgcn_rcpf(li_l[crow(r + 1, hi)]); float sa = 0.f, sb = 0.f;
#pragma unroll
    for (int d = 0; d < 4; ++d) { const unsigned q1 = __hip_atomic_load(pk + (d * 8 + (r >> 1)) * 512, __ATOMIC_RELAXED, __HIP_MEMORY_SCOPE_AGENT);     const float a = __uint_as_float(q1 << 16) - lam * (o[d][r] * ra), bq = __uint_as_float(q1 & 0xffff0000u) - lam * (o[d][r + 1] * rb);
      o[d][r] = a; o[d][r + 1] = bq; sa += a * a; sb += bq * bq; }
    sq[r] = sa; sq[r + 1] = sb; }
#pragma unroll
  for (int r = 0; r < 16; ++r) {
#pragma unroll
    for (int of = 1; of < 32; of <<= 1) sq[r] += __shfl_xor(sq[r], of); }
  float* SQX = (float*)(lds + PX_X1);
  if (r32 == 0) {
#pragma unroll
    for (int r = 0; r < 16; ++r) SQX[wid * 32 + crow(r, hi)] = sq[r]; }
  __syncthreads();
#pragma unroll
  for (int r = 0; r < 16; ++r) { const float tot = sq[r] + SQX[pw * 32 + crow(r, hi)]; sq[r] = rsqrtf(tot * (1.f / 256.f) + 1e-6f); }
  char* Wl = lds + wid * 8192 + hi * 1024 + r32 * 2;
#pragma unroll
  for (int r = 0; r < 16; r += 2) {
#pragma unroll
    for (int d0 = 0; d0 < 4; ++d0) {
      const unsigned w = cvtpk(o[d0][r] * sq[r] * gsc[d0], o[d0][r + 1] * sq[r + 1] * gsc[d0]);
      *(unsigned short*)(Wl + crow(r, 0) * 256 + d0 * 64) = (unsigned short)(w & 0xffffu);
      *(unsigned short*)(Wl + crow(r + 1, 0) * 256 + d0 * 64) = (unsigned short)(w >> 16);
    }
    SBAR();
  }
  asm volatile("s_waitcnt lgkmcnt(0)" ::: "memory");
  bf16_t* Ow = Ob + (size_t)(grp * 32) * LDO + role * 128;
#pragma unroll
  for (int i = 0; i < 8; ++i) { const int ch = i * 64 + lane, row = ch >> 4, c16 = ch & 15;
    const u32x4 v = *(const u32x4*)(lds + wid * 8192 + row * 256 + c16 * 16);
    *(u32x4*)(Ow + (size_t)row * LDO + c16 * 8) = v; }
}
#undef SBAR
}

constexpr int DM = 2048, NB = 8, SEQ = 2048, CTXL = 256, TPB = SEQ + CTXL, MT = NB * TPB;
constexpr int FF = 5632, NQKV = 6144, MLA_INP = 1280, MLA_IN = 1088;
constexpr float EPS = 1e-6f;
constexpr int NWAVES = 8;
constexpr int LDS_BYTES = 147456;
constexpr size_t MiB = 1u << 20;
constexpr size_t WS_MOD = 1 * MiB;
constexpr size_t WS_CS0 = 2 * MiB, WS_SN0 = WS_CS0 + 512 * 1024, WS_CS1 = 3 * MiB, WS_SN1 = WS_CS1 + 256 * 1024;
constexpr size_t WS_WQKV = 4 * MiB, WS_WO0 = 28 * MiB, WS_WFI0 = 36 * MiB, WS_WFI1 = 80 * MiB, WS_WFO0 = 124 * MiB, WS_WFO1 = 146 * MiB;
constexpr size_t WS_WMI = 168 * MiB, WS_WQU = 173 * MiB, WS_WKU = 176 * MiB, WS_WMO = 180 * MiB;
constexpr size_t WS_X = 188 * MiB;
constexpr size_t WS_AO = WS_X;
constexpr size_t WS_H = 332 * MiB;
constexpr size_t WS_CQN = WS_H, WS_CKVN = WS_H + 18 * MiB;
constexpr size_t WS_AN = 404 * MiB;
constexpr size_t WS_BIG = 476 * MiB;
constexpr size_t WS_KV1 = WS_BIG, WS_Q1 = WS_BIG + 144 * MiB, WS_CIN = WS_Q1, WS_KR = WS_Q1 + 108 * MiB, WS_END = WS_KR + 3 * MiB;
constexpr size_t WS_SS = 65536;
constexpr size_t WS_BIAS = WS_END, WS_END2 = WS_BIAS + 2 * MiB;
static_assert(WS_END2 <= 768 * MiB, "ws map");

#define GAS __attribute__((address_space(1)))
#define LAS __attribute__((address_space(3)))
typedef unsigned short bf16;
typedef unsigned v4u __attribute__((ext_vector_type(4)));
typedef unsigned v2u __attribute__((ext_vector_type(2)));
typedef float f32x4 __attribute__((ext_vector_type(4)));
#define LDS_WAIT() asm volatile("s_waitcnt lgkmcnt(0)" ::: "memory")
__device__ __forceinline__ unsigned pk2(float lo, float hi) { return pg8::cvt_pk_bf16(lo, hi); }
__device__ __forceinline__ float bf2f(unsigned short s) { return __uint_as_float(((unsigned)s) << 16); }
__device__ __forceinline__ float wave_sum(float v) {
#pragma unroll
    for (int o = 1; o < 64; o <<= 1) v += __shfl_xor(v, o);
    return v;
}

struct Args { const float* in[21]; float* out; unsigned char* ws; int ph_lo, ph_hi, coop, pad; };
enum { I_X = 0, I_C, I_CTX, I_CCTX, I_ADAW, I_ADAB, I_NMG, I_NFG, I_FWI, I_FWO, I_DQKV, I_DLAM, I_DSUB, I_DWO, I_MWI, I_MQG, I_MQU, I_MKG, I_MKU, I_MWO, I_FNG };

struct Frame { unsigned char* lds; unsigned char* ws; const Args* a; int tid, lane, wave, vcu, G; };

__device__ __forceinline__ int qkv_dst(int c) { const int d = c & 127, j = d & 63, n = d >> 6; return c < 4096 ? (c & ~127) + 32 * (j >> 4) + 8 * ((j >> 2) & 3) + 4 * n + (j & 3) : c; }
__device__ __forceinline__ int ffn_dst(int c) { return c < FF ? (c >> 7) * 256 + (c & 127) : ((c - FF) >> 7) * 256 + 128 + ((c - FF) & 127); }
struct TItem { const float* W; bf16* WT; int K, N, dst_n0, src_n0, k0, mode; };
__device__ __forceinline__ TItem titem_decode(const Args& A, unsigned char* ws, int it) {
    constexpr int J0 = (2048 / 64) * (6144 / 64), J1 = (2048 / 64) * (2048 / 64), J2 = (2048 / 64) * (11264 / 64), J4 = (5632 / 64) * (2048 / 64),
                  J6 = (2048 / 64) * (1088 / 64), J7 = (512 / 64) * (3072 / 64), J8 = (512 / 64) * (4096 / 64);
    TItem t; int r = it; t.mode = 0;
    if (r < J0) { const int nb = r % 96, kb = r / 96; t.W = A.in[I_DQKV]; t.WT = (bf16*)(ws + WS_WQKV); t.K = 2048; t.N = 6144; t.dst_n0 = nb * 64; t.src_n0 = nb * 64; t.k0 = kb * 64; t.mode = 1; return t; } r -= J0;
    if (r < J1) { const int nb = r % 32, kb = r / 32; t.W = A.in[I_DWO]; t.WT = (bf16*)(ws + WS_WO0); t.K = 2048; t.N = 2048; t.dst_n0 = nb * 64; t.src_n0 = nb * 64; t.k0 = kb * 64; return t; } r -= J1;
    if (r < 2 * J2) { const int l = r / J2; r -= l * J2; const int nb = r % 176, kb = r / 176; t.W = A.in[I_FWI] + (size_t)l * 2048 * 11264; t.WT = (bf16*)(ws + (l ? WS_WFI1 : WS_WFI0)); t.K = 2048; t.N = 11264;
        t.dst_n0 = ffn_dst(nb * 64); t.src_n0 = nb * 64; t.k0 = kb * 64; return t; } r -= 2 * J2;
    if (r < 2 * J4) { const int l = r / J4; r -= l * J4; const int nb = r % 32, kb = r / 32; t.W = A.in[I_FWO] + (size_t)l * 5632 * 2048; t.WT = (bf16*)(ws + (l ? WS_WFO1 : WS_WFO0)); t.K = 5632; t.N = 2048;
        t.dst_n0 = nb * 64; t.src_n0 = nb * 64; t.k0 = kb * 64; return t; } r -= 2 * J4;
    if (r < J6) { const int nb = r % 17, kb = r / 17; t.W = A.in[I_MWI]; t.WT = (bf16*)(ws + WS_WMI); t.K = 2048; t.N = 1088; t.dst_n0 = nb * 64; t.src_n0 = nb * 64; t.k0 = kb * 64; return t; } r -= J6;
    if (r < J7) { const int nb = r % 48, kb = r / 48; t.W = A.in[I_MQU]; t.WT = (bf16*)(ws + WS_WQU); t.K = 512; t.N = 3072; t.dst_n0 = nb * 64; t.src_n0 = nb * 64; t.k0 = kb * 64; return t; } r -= J7;
    if (r < J8) { const int nb = r % 64, kb = r / 64; t.W = A.in[I_MKU]; t.WT = (bf16*)(ws + WS_WKU); t.K = 512; t.N = 4096; t.dst_n0 = nb * 64; t.src_n0 = nb * 64; t.k0 = kb * 64; return t; } r -= J8;
    { const int nb = r % 32, kb = r / 32; t.W = A.in[I_MWO]; t.WT = (bf16*)(ws + WS_WMO); t.K = 2048; t.N = 2048; t.dst_n0 = nb * 64; t.src_n0 = nb * 64; t.k0 = kb * 64; return t; }
}
__device__ __forceinline__ void titem_load(const TItem& t, f32x4 (&v)[16], int lane) {
    const float* wp = t.W + (size_t)(t.k0 + (lane >> 4)) * t.N + t.src_n0 + (lane & 15) * 4;
#pragma unroll
    for (int i = 0; i < 16; ++i) v[i] = __builtin_nontemporal_load((const f32x4*)(wp + (size_t)(4 * i) * t.N));
}
__device__ __forceinline__ void titem_store(const TItem& t, const f32x4 (&v)[16], LAS float* scr, int lane) {
    LAS float* sw = scr + (lane >> 4) * 65 + (lane & 15) * 4;
#pragma unroll
    for (int i = 0; i < 16; ++i) { sw[(4 * i) * 65 + 0] = v[i].x; sw[(4 * i) * 65 + 1] = v[i].y; sw[(4 * i) * 65 + 2] = v[i].z; sw[(4 * i) * 65 + 3] = v[i].w; }
    LDS_WAIT(); asm volatile("" ::: "memory");
    const int c = lane & 7;
#pragma unroll
    for (int j = 0; j < 8; ++j) { const int n = (lane >> 3) + 8 * j; const LAS float* s = scr + (8 * c) * 65 + n;
        v4u o; o.x = pk2(s[0 * 65], s[1 * 65]); o.y = pk2(s[2 * 65], s[3 * 65]); o.z = pk2(s[4 * 65], s[5 * 65]); o.w = pk2(s[6 * 65], s[7 * 65]);
        const int drow = t.mode ? qkv_dst(t.src_n0 + n) : t.dst_n0 + n;
        *(v4u*)(t.WT + (size_t)drow * t.K + t.k0 + 8 * c) = o; }
    LDS_WAIT(); asm volatile("" ::: "memory");
}

__device__ __forceinline__ void p0_prologue(const Frame& F) {
    const Args& A = *F.a; unsigned char* ws = F.ws;
    LAS float* scr = (LAS float*)(F.lds + F.wave * 16640);
    const int gw = F.vcu * NWAVES + F.wave, NGW = F.G * NWAVES;
    constexpr int NITEMS = (2048 / 64) * (6144 / 64) + 2 * (2048 / 64) * (2048 / 64) + 2 * (2048 / 64) * (11264 / 64) + 2 * (5632 / 64) * (2048 / 64) + (2048 / 64) * (1088 / 64) + (512 / 64) * (3072 / 64) + (512 / 64) * (4096 / 64);
    {
        f32x4 va[16], vb[16]; int it = gw;
        if (it < NITEMS) { TItem ta = titem_decode(A, ws, it); titem_load(ta, va, F.lane);
            for (;;) {
                const int itb = it + NGW; TItem tb = ta; const bool hb = itb < NITEMS; if (hb) { tb = titem_decode(A, ws, itb); titem_load(tb, vb, F.lane); }
                titem_store(ta, va, scr, F.lane); if (!hb) break;
                const int ita = itb + NGW; const bool ha = ita < NITEMS; if (ha) { ta = titem_decode(A, ws, ita); titem_load(ta, va, F.lane); }
                titem_store(tb, vb, scr, F.lane); if (!ha) break;
                it = ita; } }
    }
    const int gt = F.vcu * 512 + F.tid, NGT = F.G * 512;
    { v4u* z = (v4u*)((bf16*)(ws + WS_WMI) + (size_t)MLA_IN * 2048); const int nz = (MLA_INP - MLA_IN) * 2048 / 8;
      for (int i = gt; i < nz; i += NGT) z[i] = (v4u){0u, 0u, 0u, 0u}; }
    { float* ssz = (float*)(ws + WS_SS); for (int i = gt; i < 3 * MT; i += NGT) ssz[i] = 0.f; }
    for (int i = gt; i < 2048 * 96; i += NGT) {
        const bool l1 = i >= 2048 * 64; const int k = l1 ? i - 2048 * 64 : i; const int nf = l1 ? 16 : 32; const int t = k / (2 * nf), j = k % (2 * nf);
        const float pos = (float)(j < nf ? t / 64 : t % 64); const int f = j < nf ? j : j - nf;
        const float inv = exp2f(-(float)f / (float)nf * 13.287712379549449f);
        const float ang = pos * inv; double rv = (double)ang * 0.15915494309189535; rv -= floor(rv); const float rf = (float)rv;
        const float cv = __builtin_amdgcn_cosf(rf), sv = __builtin_amdgcn_sinf(rf);
        if (l1) { ((float*)(ws + WS_CS1))[k] = cv; ((float*)(ws + WS_SN1))[k] = sv; } else { ((float*)(ws + WS_CS0))[k] = cv; ((float*)(ws + WS_SN0))[k] = sv; }
    }
    __syncthreads();
    LAS float* sc = (LAS float*)F.lds; LAS float* red = (LAS float*)(F.lds + 9 * 2048 * 4);
    for (int i = F.tid; i < 9 * 2048; i += 512) { const int r = i >> 11, k = i & 2047; const float v = r < 8 ? A.in[I_C][r * 2048 + k] : A.in[I_CCTX][k]; sc[i] = v / (1.f + expf(-v)); }
    __syncthreads();
    for (int u = blockIdx.x; u < 768; u += F.G) {
        const int layer = u / 384, n0 = (u % 384) * 32, c4 = F.tid & 7, kg = F.tid >> 3;
        const float* w = A.in[I_ADAW] + (size_t)layer * 2048 * 12288 + (size_t)(kg * 32) * 12288 + n0 + c4 * 4;
        f32x4 acc[9];
#pragma unroll
        for (int r = 0; r < 9; ++r) acc[r] = (f32x4){0.f, 0.f, 0.f, 0.f};
#pragma unroll
        for (int k = 0; k < 32; k += 8) {
            f32x4 wv[8];
#pragma unroll
            for (int q = 0; q < 8; ++q) wv[q] = __builtin_nontemporal_load((const f32x4*)(w + (size_t)(k + q) * 12288));
#pragma unroll
            for (int r = 0; r < 9; ++r) { const f32x4 s0 = *(const LAS f32x4*)(sc + r * 2048 + kg * 32 + k), s1 = *(const LAS f32x4*)(sc + r * 2048 + kg * 32 + k + 4);
                acc[r] += (wv[0] * s0.x + wv[1] * s0.y) + (wv[2] * s0.z + wv[3] * s0.w) + (wv[4] * s1.x + wv[5] * s1.y) + (wv[6] * s1.z + wv[7] * s1.w); }
        }
#pragma unroll
        for (int r = 0; r < 9; ++r) {
#pragma unroll
            for (int e = 0; e < 4; ++e) { float x = acc[r][e]; x += __shfl_xor(x, 8); x += __shfl_xor(x, 16); x += __shfl_xor(x, 32); acc[r][e] = x; } }
        if (F.lane < 8) {
#pragma unroll
            for (int r = 0; r < 9; ++r) *(LAS f32x4*)(red + (F.wave * 9 + r) * 32 + c4 * 4) = acc[r]; }
        __syncthreads();
        if (F.tid < 288) { const int r = F.tid >> 5, c2 = F.tid & 31; float s = 0.f;
#pragma unroll
            for (int g = 0; g < 8; ++g) s += red[(g * 9 + r) * 32 + c2];
            ((float*)(ws + WS_MOD))[(size_t)(layer * 9 + r) * 12288 + n0 + c2] = s + A.in[I_ADAB][layer * 12288 + n0 + c2]; }
        __syncthreads();
    }
}

__device__ __forceinline__ void norm_phase(const Frame& F, int layer, int which, bool from_input, bool lat_only) {
    const Args& A = *F.a; const int gw = F.vcu * NWAVES + F.wave, NGW = F.G * NWAVES;
    const float* g = (which ? A.in[I_NFG] : A.in[I_NMG]) + layer * 2048;
    const float* X = (const float*)(F.ws + WS_X); bf16* H = (bf16*)(F.ws + WS_H);
    for (int m0 = gw; m0 < MT; m0 += 2 * NGW) {
        f32x4 v[2][8]; const float* shift[2]; bool ok[2]; int mm[2];
#pragma unroll
        for (int q = 0; q < 2; ++q) { const int m = m0 + q * NGW; mm[q] = m; const int b = m / TPB, r = m - b * TPB; ok[q] = m < MT && !(lat_only && r < CTXL);
            const float* src = from_input ? (r < CTXL ? A.in[I_CTX] + ((size_t)b * CTXL + r) * 2048 : A.in[I_X] + ((size_t)b * SEQ + (r - CTXL)) * 2048) : X + (size_t)m * 2048;
            shift[q] = (const float*)(F.ws + WS_MOD) + (size_t)(layer * 9 + (r < CTXL ? 8 : b)) * 12288 + which * 3 * 2048;
            if (ok[q]) { const f32x4* xr = (const f32x4*)src + F.lane;
#pragma unroll
                for (int j = 0; j < 8; ++j) v[q][j] = from_input ? __builtin_nontemporal_load(xr + 64 * j) : xr[64 * j]; } }
#pragma unroll
        for (int q = 0; q < 2; ++q) if (ok[q]) { float s = 0.f;
#pragma unroll
            for (int j = 0; j < 8; ++j) s += (v[q][j].x * v[q][j].x + v[q][j].y * v[q][j].y) + (v[q][j].z * v[q][j].z + v[q][j].w * v[q][j].w);
            const float rstd = rsqrtf(wave_sum(s) * (1.f / 2048.f) + EPS); const float* scale = shift[q] + 2048;
            v2u* o8 = (v2u*)(H + (size_t)mm[q] * 2048) + F.lane;
#pragma unroll
            for (int j = 0; j < 8; ++j) { const f32x4 gg = ((const f32x4*)g)[64 * j + F.lane], sc = ((const f32x4*)scale)[64 * j + F.lane], sh = ((const f32x4*)shift[q])[64 * j + F.lane];
                const f32x4 y = (v[q][j] * rstd * gg) * (sc + 1.f) + sh; v2u w; w.x = pk2(y.x, y.y); w.y = pk2(y.z, y.w); o8[64 * j] = w; } }
    }
}

__device__ __forceinline__ void bias_phase(const Frame& F) {
    const int gw = F.vcu * NWAVES + F.wave, NGW = F.G * NWAVES; const int fr = F.lane & 15, fq = F.lane >> 4;
    const float* MOD = (const float*)(F.ws + WS_MOD); float* BIAS = (float*)(F.ws + WS_BIAS);
    constexpr int NB0 = 11264 / 16, NB1 = MLA_INP / 16, NBT = 2 * NB0 + NB1;
    for (int it = gw; it < NBT; it += NGW) {
        int j, nb; if (it < NB0) { j = 0; nb = it; } else if (it < NB0 + NB1) { j = 1; nb = it - NB0; } else { j = 2; nb = it - NB0 - NB1; }
        const bf16* Wt = (const bf16*)(F.ws + (j == 0 ? WS_WFI0 : j == 1 ? WS_WMI : WS_WFI1)); const int N = j == 1 ? MLA_INP : 11264;
        const float* sh = MOD + (size_t)((j ? 9 : 0) + (fr < 9 ? fr : 0)) * 12288 + (j == 1 ? 0 : 3 * 2048) + fq * 8;
        const bf16* wp = Wt + (size_t)(nb * 16 + fr) * 2048 + fq * 8;
        pg8::f32x4 acc = {0.f, 0.f, 0.f, 0.f};
#pragma unroll 4
        for (int k0 = 0; k0 < 2048; k0 += 32) {
            const pg8::bf16x8 a = *(const pg8::bf16x8*)(wp + k0);
            v4u bw = {0u, 0u, 0u, 0u};
            if (fr < 9) { const f32x4 s0 = *(const f32x4*)(sh + k0), s1 = *(const f32x4*)(sh + k0 + 4); bw.x = pk2(s0.x, s0.y); bw.y = pk2(s0.z, s0.w); bw.z = pk2(s1.x, s1.y); bw.w = pk2(s1.z, s1.w); }
            acc = __builtin_amdgcn_mfma_f32_16x16x32_bf16(a, *(pg8::bf16x8*)&bw, acc, 0, 0, 0);
        }
        if (fr < 9) *(f32x4*)(BIAS + ((size_t)j * 9 + fr) * 11264 + nb * 16 + fq * 4) = acc;
    }
}

__device__ __forceinline__ void rope0_phase(const Frame& F) {
    const int gw = F.vcu * NWAVES + F.wave, NGW = F.G * NWAVES;
    bf16* QKV = (bf16*)(F.ws + WS_BIG); const float* CS = (const float*)(F.ws + WS_CS0); const float* SN = (const float*)(F.ws + WS_SN0);
    for (int lr = gw; lr < NB * SEQ; lr += NGW) {
        const int b = lr >> 11, t = lr & 2047; bf16* row = QKV + ((size_t)b * TPB + CTXL + t) * NQKV;
#pragma unroll
        for (int it = 0; it < 4; ++it) { const int idx = it * 64 + F.lane, grp = idx >> 3, j0 = (idx & 7) * 8;
            v4u a = *(const v4u*)(row + grp * 128 + j0), bq = *(const v4u*)(row + grp * 128 + 64 + j0);
            const f32x4 c0 = *(const f32x4*)(CS + t * 64 + j0), c1 = *(const f32x4*)(CS + t * 64 + j0 + 4), s0 = *(const f32x4*)(SN + t * 64 + j0), s1 = *(const f32x4*)(SN + t * 64 + j0 + 4);
            v4u oa, ob;
#pragma unroll
            for (int q = 0; q < 4; ++q) {
                const float x1l = __uint_as_float(a[q] << 16), x1h = __uint_as_float(a[q] & 0xffff0000u), x2l = __uint_as_float(bq[q] << 16), x2h = __uint_as_float(bq[q] & 0xffff0000u);
                const float cl = q < 2 ? c0[2 * q] : c1[2 * q - 4], ch = q < 2 ? c0[2 * q + 1] : c1[2 * q - 3], sl = q < 2 ? s0[2 * q] : s1[2 * q - 4], sh = q < 2 ? s0[2 * q + 1] : s1[2 * q - 3];
                oa[q] = pk2(x1l * cl - x2l * sl, x1h * ch - x2h * sh); ob[q] = pk2(x1l * sl + x2l * cl, x1h * sh + x2h * ch); }
            *(v4u*)(row + grp * 128 + j0) = oa; *(v4u*)(row + grp * 128 + 64 + j0) = ob; }
    }
}

__device__ __forceinline__ void combine_phase(const Frame& F) {
    const Args& A = *F.a; const int gw = F.vcu * NWAVES + F.wave, NGW = F.G * NWAVES;
    const float* lv = A.in[I_DLAM];
    const float s1 = wave_sum(lv[F.lane] * lv[128 + F.lane] + lv[64 + F.lane] * lv[192 + F.lane]);
    const float s2 = wave_sum(lv[256 + F.lane] * lv[384 + F.lane] + lv[320 + F.lane] * lv[448 + F.lane]);
    const float lam_init = 0.2f, lam = expf(s1) - expf(s2) + lam_init;
    const int l32 = F.lane & 31; const bool lo = F.lane < 32;
    const f32x4 g0 = ((const f32x4*)A.in[I_DSUB])[2 * l32], g1 = ((const f32x4*)A.in[I_DSUB])[2 * l32 + 1];
    const bf16* AO = (const bf16*)(F.ws + WS_AO); bf16* AN = (bf16*)(F.ws + WS_AN);
    for (int m = gw; m < MT; m += NGW) {
        v4u a[8];
#pragma unroll
        for (int h = 0; h < 8; ++h) a[h] = *((const v4u*)(AO + (size_t)m * 4096 + h * 512) + F.lane);
#pragma unroll
        for (int h = 0; h < 8; ++h) {
            v4u o; float d[8]; float ss = 0.f;
#pragma unroll
            for (int q = 0; q < 4; ++q) { o[q] = __shfl_xor((int)a[h][q], 32); }
#pragma unroll
            for (int q = 0; q < 4; ++q) { const unsigned p1 = lo ? a[h][q] : o[q], p2 = lo ? o[q] : a[h][q];
                d[2 * q] = __uint_as_float(p1 << 16) - lam * __uint_as_float(p2 << 16); d[2 * q + 1] = __uint_as_float(p1 & 0xffff0000u) - lam * __uint_as_float(p2 & 0xffff0000u);
                ss += d[2 * q] * d[2 * q] + d[2 * q + 1] * d[2 * q + 1]; }
#pragma unroll
            for (int of = 1; of < 32; of <<= 1) ss += __shfl_xor(ss, of);
            const float rstd = rsqrtf(ss * (1.f / 256.f) + EPS) * (1.f - lam_init);
            v4u w; w.x = pk2(d[0] * rstd * g0.x, d[1] * rstd * g0.y); w.y = pk2(d[2] * rstd * g0.z, d[3] * rstd * g0.w);
            w.z = pk2(d[4] * rstd * g1.x, d[5] * rstd * g1.y); w.w = pk2(d[6] * rstd * g1.z, d[7] * rstd * g1.w);
            if (lo) *((v4u*)(AN + (size_t)m * 2048 + h * 256) + l32) = w;
        }
    }
}

__device__ __forceinline__ void mla_norm_phase(const Frame& F) {
    const Args& A = *F.a; const int gw = F.vcu * NWAVES + F.wave, NGW = F.G * NWAVES;
    const bf16* CIN = (const bf16*)(F.ws + WS_CIN); bf16* CQN = (bf16*)(F.ws + WS_CQN); bf16* CKVN = (bf16*)(F.ws + WS_CKVN); bf16* KR = (bf16*)(F.ws + WS_KR);
    const float* CS = (const float*)(F.ws + WS_CS1); const float* SN = (const float*)(F.ws + WS_SN1);
    const f32x4 gq0 = ((const f32x4*)A.in[I_MQG])[2 * F.lane], gq1 = ((const f32x4*)A.in[I_MQG])[2 * F.lane + 1];
    const f32x4 gk0 = ((const f32x4*)A.in[I_MKG])[2 * F.lane], gk1 = ((const f32x4*)A.in[I_MKG])[2 * F.lane + 1];
    for (int m = gw; m < MT; m += NGW) {
        const bf16* row = CIN + (size_t)m * MLA_INP;
#pragma unroll
        for (int p = 0; p < 2; ++p) {
            const v4u a = *((const v4u*)(row + p * 512) + F.lane); float x[8];
#pragma unroll
            for (int q = 0; q < 4; ++q) { x[2 * q] = __uint_as_float(a[q] << 16); x[2 * q + 1] = __uint_as_float(a[q] & 0xffff0000u); }
            float s = 0.f;
#pragma unroll
            for (int e = 0; e < 8; ++e) s += x[e] * x[e];
            const float rstd = rsqrtf(wave_sum(s) * (1.f / 512.f) + EPS);
            const f32x4 g0 = p ? gk0 : gq0, g1 = p ? gk1 : gq1;
            v4u w; w.x = pk2(x[0] * rstd * g0.x, x[1] * rstd * g0.y); w.y = pk2(x[2] * rstd * g0.z, x[3] * rstd * g0.w);
            w.z = pk2(x[4] * rstd * g1.x, x[5] * rstd * g1.y); w.w = pk2(x[6] * rstd * g1.z, x[7] * rstd * g1.w);
            *((v4u*)((p ? CKVN : CQN) + (size_t)m * 512) + F.lane) = w;
        }
        const int b = m / TPB, r = m - b * TPB;
        if (F.lane < 4) {
            const v4u a = *((const v4u*)(row + 1024) + F.lane), bq = *((const v4u*)(row + 1024 + 32) + F.lane);
            v4u oa = a, ob = bq;
            if (r >= CTXL) { const int t = r - CTXL, j0 = F.lane * 8;
                const f32x4 c0 = *(const f32x4*)(CS + t * 32 + j0), c1 = *(const f32x4*)(CS + t * 32 + j0 + 4), s0 = *(const f32x4*)(SN + t * 32 + j0), s1 = *(const f32x4*)(SN + t * 32 + j0 + 4);
#pragma unroll
                for (int q = 0; q < 4; ++q) {
                    const float x1l = __uint_as_float(a[q] << 16), x1h = __uint_as_float(a[q] & 0xffff0000u), x2l = __uint_as_float(bq[q] << 16), x2h = __uint_as_float(bq[q] & 0xffff0000u);
                    const float cl = q < 2 ? c0[2 * q] : c1[2 * q - 4], ch = q < 2 ? c0[2 * q + 1] : c1[2 * q - 3], sl = q < 2 ? s0[2 * q] : s1[2 * q - 4], sh = q < 2 ? s0[2 * q + 1] : s1[2 * q - 3];
                    oa[q] = pk2(x1l * cl - x2l * sl, x1h * ch - x2h * sh); ob[q] = pk2(x1l * sl + x2l * cl, x1h * sh + x2h * ch); } }
            *((v4u*)(KR + (size_t)m * 64) + F.lane) = oa; *((v4u*)(KR + (size_t)m * 64 + 32) + F.lane) = ob;
        }
    }
}

__device__ __forceinline__ void final_phase(const Frame& F) {
    const Args& A = *F.a; const int gw = F.vcu * NWAVES + F.wave, NGW = F.G * NWAVES;
    const float* X = (const float*)(F.ws + WS_X); const float* g = A.in[I_FNG];
    for (int lr0 = gw; lr0 < NB * SEQ; lr0 += 2 * NGW) {
        f32x4 v[2][8];
#pragma unroll
        for (int q = 0; q < 2; ++q) { const int lr = lr0 + q * NGW; if (lr < NB * SEQ) { const int b = lr >> 11, t = lr & 2047; const f32x4* xr = (const f32x4*)(X + ((size_t)b * TPB + CTXL + t) * 2048) + F.lane;
#pragma unroll
            for (int j = 0; j < 8; ++j) v[q][j] = xr[64 * j]; } }
#pragma unroll
        for (int q = 0; q < 2; ++q) { const int lr = lr0 + q * NGW; if (lr < NB * SEQ) { float s = 0.f;
#pragma unroll
            for (int j = 0; j < 8; ++j) s += (v[q][j].x * v[q][j].x + v[q][j].y * v[q][j].y) + (v[q][j].z * v[q][j].z + v[q][j].w * v[q][j].w);
            const float rstd = rsqrtf(wave_sum(s) * (1.f / 2048.f) + EPS);
            f32x4* o = (f32x4*)(A.out + (size_t)lr * 2048) + F.lane;
#pragma unroll
            for (int j = 0; j < 8; ++j) __builtin_nontemporal_store(v[q][j] * rstd * ((const f32x4*)g)[64 * j + F.lane], o + 64 * j); } }
    }
}

__device__ __forceinline__ void attn0_phase(const Frame& F) {
    const bf16* QKV = (const bf16*)(F.ws + WS_BIG); bf16* AO = (bf16*)(F.ws + WS_AO);
#if ATT0_PX
    const Args& A = *F.a; const float* lv = A.in[I_DLAM];
    const float s1 = wave_sum(lv[F.lane] * lv[128 + F.lane] + lv[64 + F.lane] * lv[192 + F.lane]);
    const float s2 = wave_sum(lv[256 + F.lane] * lv[384 + F.lane] + lv[320 + F.lane] * lv[448 + F.lane]);
    const float lam = expf(s1) - expf(s2) + 0.2f;
    bf16* AN = (bf16*)(F.ws + WS_AN);
    for (int li = F.vcu; li < 1024 + 128; li += F.G) {
        int b, h, qrow0, seq;
        if (li < 1024) { const int qb = li & 15; h = (li >> 4) & 7; b = li >> 7; qrow0 = b * TPB + CTXL + qb * 128; seq = TPB; }
        else { const int ci = li - 1024; const int qb = ci & 1; h = (ci >> 1) & 7; b = ci >> 4; qrow0 = b * TPB + qb * 128; seq = CTXL; }
        const bf16* kb = QKV + (size_t)b * TPB * NQKV;
        att::attn_px_body(QKV + (size_t)qrow0 * NQKV + h * 256, kb + 2048 + h * 256, kb + 4096 + h * 256, AN + (size_t)qrow0 * 2048 + h * 256, seq, lam, A.in[I_DSUB], (unsigned*)(F.ws + WS_AO) + (size_t)blockIdx.x * 16384, (char*)F.lds);
    }
#else
    for (int li = F.vcu; li < 2048 + 256; li += F.G) {
        int b, mp, vh, qrow0, seq;
        if (li < 2048) { const int qb = li & 7; vh = (li >> 3) & 1; mp = (li >> 4) & 15; b = li >> 8; qrow0 = b * TPB + CTXL + qb * 256; seq = TPB; }
        else { const int ci = li - 2048; vh = ci & 1; mp = (ci >> 1) & 15; b = ci >> 5; qrow0 = b * TPB; seq = CTXL; }
        const bf16* kb = QKV + (size_t)b * TPB * NQKV;
        att::attn_body<128, ATT0_SDEPTH, NQKV, NQKV, NQKV, 4096>(QKV + (size_t)qrow0 * NQKV + mp * 128, kb + 2048 + mp * 128, nullptr, kb + 4096 + (mp >> 1) * 256 + vh * 128,
                               AO + (size_t)qrow0 * 4096 + mp * 256 + vh * 128, seq, nullptr, nullptr, (char*)F.lds);
    }
#endif
}
__device__ __forceinline__ void attn1_phase(const Frame& F) {
    const bf16* Q1 = (const bf16*)(F.ws + WS_Q1); const bf16* KV1 = (const bf16*)(F.ws + WS_KV1); const bf16* KR = (const bf16*)(F.ws + WS_KR); bf16* AN = (bf16*)(F.ws + WS_AN);
    const float* CS = (const float*)(F.ws + WS_CS1); const float* SN = (const float*)(F.ws + WS_SN1);
    for (int li = F.vcu; li < 1024; li += F.G) {
        const int qb = li & 7, h = (li >> 3) & 15, b = li >> 7; const int qrow0 = b * TPB + CTXL + qb * 256;
        const bf16* kb = KV1 + (size_t)b * TPB * 4096 + h * 256;
        att::attn_body<192, ATT1_SDEPTH, 3072, 4096, 4096, 2048>(Q1 + (size_t)qrow0 * 3072 + h * 192, kb, KR + (size_t)b * TPB * 64, kb + 128,
                                         AN + (size_t)qrow0 * 2048 + h * 128, TPB, CS + (size_t)qb * 256 * 32, SN + (size_t)qb * 256 * 32, (char*)F.lds);
    }
}

#define XB_TMO      128
#define XB_XCNT(j)  (256  + 64 * (j))
#define XB_XSUB(j)  (1280 + 64 * (j))
#define XB_XGEN(j)  (2304 + 64 * (j))
#define XB_TOP      3328
#define XB_TOPGEN   3392
#define XCD_BAR_WORDS 3456
#define XB_SPIN_CAP (1u << 18)

__device__ __forceinline__ unsigned xb_ld(unsigned* p)              { return __hip_atomic_load(p, __ATOMIC_RELAXED, __HIP_MEMORY_SCOPE_AGENT); }
__device__ __forceinline__ unsigned xb_add(unsigned* p, unsigned v) { return __hip_atomic_fetch_add(p, v, __ATOMIC_RELAXED, __HIP_MEMORY_SCOPE_AGENT); }
__device__ __forceinline__ unsigned xb_xcc_id() { return (unsigned)__builtin_amdgcn_s_getreg((3 << 11) | 20) & 0xFu; }
#define XB_SPIN(cond, bar) do { unsigned _sp = 0; while (cond) { __builtin_amdgcn_s_sleep(1); \
    if ((++_sp & 255u) == 0u) { if (xb_ld(&(bar)[XB_TMO])) break; if (_sp > XB_SPIN_CAP) { atomicAdd(&(bar)[XB_TMO], 1u); break; } } } } while (0)

struct XcdBarrier {
    unsigned* bar; unsigned x;
    volatile LAS unsigned* st;
};

__device__ __forceinline__ XcdBarrier xcd_barrier_post(unsigned* bar, volatile LAS unsigned* st) {
    XcdBarrier b; b.bar = bar; b.x = xb_xcc_id(); b.st = st;
    if (threadIdx.x == 0) (void)xb_add(&bar[XB_XCNT(b.x)], 1u);
    return b;
}
__device__ __forceinline__ void xcd_barrier_complete(unsigned* bar, unsigned x, unsigned& nloc, unsigned& nx) {
    const unsigned G = gridDim.x * gridDim.y * gridDim.z;
    unsigned sum, cnt, mine, sp = 0u;
    for (;;) {
        sum = 0u; cnt = 0u; mine = 0u;
#pragma unroll
        for (unsigned j = 0; j < 16; ++j) { const unsigned c = xb_ld(&bar[XB_XCNT(j)]); sum += c; cnt += (c > 0u) ? 1u : 0u; mine = (j == x) ? c : mine; }
        if (sum == G) break;
        __builtin_amdgcn_s_sleep(1);
        if ((++sp & 255u) == 0u) { if (xb_ld(&bar[XB_TMO])) break; if (sp > XB_SPIN_CAP) { atomicAdd(&bar[XB_TMO], 1u); break; } }
    }
    nloc = mine > 0u ? mine : 1u; nx = cnt > 0u ? cnt : 1u;
}

__device__ __forceinline__ void xcd_barrier(const XcdBarrier& b) {
    asm volatile("s_waitcnt vmcnt(0)" ::: "memory");
    __syncthreads();
    if (threadIdx.x == 0) {
        unsigned* bar = b.bar;
        __builtin_amdgcn_s_waitcnt(0);
        unsigned nloc = b.st[0], nx = b.st[1];
        if (nloc == 0u) { xcd_barrier_complete(bar, b.x, nloc, nx); b.st[0] = nloc; b.st[1] = nx; }
        const unsigned old = xb_add(&bar[XB_XSUB(b.x)], 1u);
        const unsigned gen = old / nloc;
        if (old + 1u == (gen + 1u) * nloc) {
            __builtin_amdgcn_fence(__ATOMIC_RELEASE, "agent");
            asm volatile("s_waitcnt vmcnt(0)" ::: "memory");
            const unsigned og = xb_add(&bar[XB_TOP], 1u);
            const unsigned tg = og / nx;
            if (og + 1u == (tg + 1u) * nx) xb_add(&bar[XB_TOPGEN], 1u);
            else XB_SPIN(xb_ld(&bar[XB_TOPGEN]) == tg, bar);
            __builtin_amdgcn_fence(__ATOMIC_ACQUIRE, "agent");
            xb_add(&bar[XB_XGEN(b.x)], 1u);
            asm volatile("s_waitcnt vmcnt(0)" ::: "memory");
        } else {
            XB_SPIN(xb_ld(&bar[XB_XGEN(b.x)]) == gen, bar);
            __builtin_amdgcn_fence(__ATOMIC_ACQUIRE, "agent");
            asm volatile("s_waitcnt vmcnt(0)" ::: "memory");
        }
    }
    __syncthreads();
}

constexpr int NPH = 20;
__global__ void __launch_bounds__(NWAVES * 64, 2) fwd_mega(Args args) {
    extern __shared__ __attribute__((aligned(16))) unsigned char lds[];
    Frame F; F.lds = lds; F.ws = args.ws; F.a = &args;
#define REFRESH() do { F.tid = fresh_tid(); F.lane = F.tid & 63; F.wave = __builtin_amdgcn_readfirstlane(F.tid >> 6); } while (0)
    REFRESH();
    F.G = gridDim.x; { const int bx = blockIdx.x; F.vcu = (F.G % 8 == 0) ? (bx % 8) * (F.G / 8) + bx / 8 : bx; }
    const int lo = args.ph_lo, hi = args.ph_hi;
    unsigned char* ws = args.ws; float* MOD = (float*)(ws + WS_MOD); float* SSQ = (float*)(ws + WS_SS); const float* BIAS = (const float*)(ws + WS_BIAS);
    PG8_LAS unsigned char* glds = (PG8_LAS unsigned char*)lds;
#define IN(k) (lo <= (k) && (k) < hi)
#if PROBE_MASK
    unsigned long long t_acc = 0, t_prev = __builtin_amdgcn_s_memrealtime();
#define PROBE_AT(k) do { const unsigned long long now_ = __builtin_amdgcn_s_memrealtime(); if ((PROBE_MASK >> (k)) & 1) t_acc += now_ - t_prev; t_prev = now_; } while (0)
#else
#define PROBE_AT(k) do { } while (0)
#endif
#define SEAM(k) do { if (IN(k) && IN((k) + 1)) xcd_barrier(bar); } while (0)
#define DBL(k) (((PROBE_DBL >> (k)) & 1) ? 2 : 1)
    unsigned* barw = (unsigned*)(ws + 4096);
    volatile LAS unsigned* bst = (volatile LAS unsigned*)((LAS unsigned char*)lds + LDS_BYTES - 16);
    XcdBarrier bar; bar.bar = barw; bar.x = 0; bar.st = bst;
    if (args.coop) {
        if (blockIdx.x == 0) for (int i = threadIdx.x; i < XCD_BAR_WORDS; i += NWAVES * 64) __hip_atomic_store(barw + i, 0u, __ATOMIC_RELAXED, __HIP_MEMORY_SCOPE_AGENT);
        if (threadIdx.x < 2) bst[threadIdx.x] = 0u;
        cg::this_grid().sync();
        bar = xcd_barrier_post(barw, bst);
    }
#define GEMM_PHASE(EPI, Aoff, Boff, M_, N_, K_, LAT, ...) do { pg8::Gemm g{(const bf16*)(ws + (Aoff)), (const bf16*)(ws + (Boff)), M_, N_, K_}; pg8::StaticOrder S; S.init(M_, N_, F.G, (int)blockIdx.x, LAT); \
        pg8::EPI E{__VA_ARGS__}; pg8::gemm_phase<pg8::EPI, pg8::StaticOrder, true, true>(glds, g, S, E); } while (0)

    if (IN(0)) for (int rep_ = 0; rep_ < DBL(0); ++rep_) { REFRESH(); p0_prologue(F); } SEAM(0);
    if (IN(1)) for (int rep_ = 0; rep_ < DBL(1); ++rep_) { REFRESH(); norm_phase(F, 0, 0, true, false); bias_phase(F); } SEAM(1);
    if (IN(2)) for (int rep_ = 0; rep_ < DBL(2); ++rep_) { GEMM_PHASE(EpiQKV, WS_H, WS_WQKV, MT, NQKV, 2048, 0, (bf16*)(ws + WS_BIG), NQKV, (const float*)(ws + WS_CS0), (const float*)(ws + WS_SN0)); } SEAM(2);
    if (IN(4)) for (int rep_ = 0; rep_ < DBL(4); ++rep_) { REFRESH(); attn0_phase(F); } SEAM(4);
    if (IN(5)) for (int rep_ = 0; rep_ < DBL(5); ++rep_) { REFRESH(); if (!ATT0_PX) combine_phase(F); } if (!ATT0_PX) SEAM(5);
    if (IN(6)) { GEMM_PHASE(EpiRes, WS_AN, WS_WO0, MT, 2048, 2048, 0, (float*)(ws + WS_X), args.in[I_X], args.in[I_CTX], MOD + 2 * 2048, (bf16*)(ws + WS_H), args.in[I_NFG], MOD + 4 * 2048, SSQ); } SEAM(6);
    if (IN(8)) for (int rep_ = 0; rep_ < DBL(8); ++rep_) { GEMM_PHASE(EpiSwiGLU, WS_H, WS_WFI0, MT, 2 * FF, 2048, 0, (bf16*)(ws + WS_BIG), FF, SSQ, BIAS); } SEAM(8);
    if (IN(9)) { GEMM_PHASE(EpiRes, WS_BIG, WS_WFO0, MT, 2048, FF, 0, (float*)(ws + WS_X), nullptr, nullptr, MOD + 5 * 2048, (bf16*)(ws + WS_H), args.in[I_NMG] + 2048, MOD + 9 * 12288 + 1 * 2048, SSQ + MT); } SEAM(9);
    if (IN(11)) for (int rep_ = 0; rep_ < DBL(11); ++rep_) { GEMM_PHASE(EpiBf16, WS_H, WS_WMI, MT, MLA_INP, 2048, 0, (bf16*)(ws + WS_CIN), MLA_INP, SSQ + MT, BIAS + 9 * 11264, 11264); } SEAM(11);
    if (IN(12)) for (int rep_ = 0; rep_ < DBL(12); ++rep_) { REFRESH(); mla_norm_phase(F); } SEAM(12);
    if (IN(13)) for (int rep_ = 0; rep_ < DBL(13); ++rep_) { GEMM_PHASE(EpiBf16, WS_CKVN, WS_WKU, MT, 4096, 512, 0, (bf16*)(ws + WS_KV1), 4096, nullptr, nullptr, 0);
                  GEMM_PHASE(EpiBf16, WS_CQN, WS_WQU, MT, 3072, 512, 1, (bf16*)(ws + WS_Q1), 3072, nullptr, nullptr, 0); } SEAM(13);
    if (IN(14)) for (int rep_ = 0; rep_ < DBL(14); ++rep_) { REFRESH(); attn1_phase(F); } SEAM(14);
    if (IN(15)) { GEMM_PHASE(EpiRes, WS_AN, WS_WMO, MT, 2048, 2048, 1, (float*)(ws + WS_X), nullptr, nullptr, MOD + 9 * 12288 + 2 * 2048, (bf16*)(ws + WS_H), args.in[I_NFG] + 2048, MOD + 9 * 12288 + 4 * 2048, SSQ + 2 * MT); } SEAM(15);
    if (IN(17)) for (int rep_ = 0; rep_ < DBL(17); ++rep_) { GEMM_PHASE(EpiSwiGLU, WS_H, WS_WFI1, MT, 2 * FF, 2048, 1, (bf16*)(ws + WS_BIG), FF, SSQ + 2 * MT, BIAS + 2 * 9 * 11264); } SEAM(17);
    if (IN(18)) { GEMM_PHASE(EpiRes, WS_BIG, WS_WFO1, MT, 2048, FF, 1, (float*)(ws + WS_X), nullptr, nullptr, MOD + 9 * 12288 + 5 * 2048, nullptr, nullptr, nullptr, nullptr); } SEAM(18);
    if (IN(19)) for (int rep_ = 0; rep_ < DBL(19); ++rep_) { REFRESH(); final_phase(F); }
#if PROBE_MASK
    __syncthreads(); PROBE_AT(19);
    if (blockIdx.x == 0 && threadIdx.x == 0) args.out[0] = (float)t_acc * 0.01f;
#endif
#undef IN
#undef SEAM
#undef GEMM_PHASE
}

extern "C" void kernel_launch(void* const* d_in, const int* in_sizes, int n_in, void* d_out, int out_size, void* d_ws, size_t ws_size, hipStream_t stream) {
    static int grid = 0;
    if (grid == 0) {
        if (n_in != 21 || in_sizes[0] != NB * SEQ * DM || out_size != NB * SEQ * DM || ws_size < WS_END2) {
            fprintf(stderr, "kernel_launch: shape mismatch (n_in %d in0 %d out %d ws %zu, need ws >= %zu); nothing launched\n", n_in, n_in > 0 ? in_sizes[0] : -1, out_size, ws_size, (size_t)WS_END2); grid = -1; return; }
        int dev = 0, cus = 0, per_cu = 0;
        if (hipGetDevice(&dev) != hipSuccess || hipDeviceGetAttribute(&cus, hipDeviceAttributeMultiprocessorCount, dev) != hipSuccess) { fprintf(stderr, "kernel_launch: device query failed\n"); grid = -1; return; }
        if (hipFuncSetAttribute((const void*)fwd_mega, hipFuncAttributeMaxDynamicSharedMemorySize, LDS_BYTES) != hipSuccess) { fprintf(stderr, "kernel_launch: hipFuncSetAttribute failed\n"); grid = -1; return; }
        if (hipOccupancyMaxActiveBlocksPerMultiprocessor(&per_cu, (const void*)fwd_mega, NWAVES * 64, LDS_BYTES) != hipSuccess || per_cu < 1) { fprintf(stderr, "kernel_launch: occupancy query says %d\n", per_cu); per_cu = 1; }
        (void)hipGetLastError();
        grid = cus * 1;
    }
    if (grid < 0) return;
    Args a{};
    for (int i = 0; i < 21; ++i) a.in[i] = (const float*)d_in[i];
    a.out = (float*)d_out; a.ws = (unsigned char*)d_ws;
#if ONE_LAUNCH
    a.ph_lo = 0; a.ph_hi = NPH; a.coop = 1;
    void* kargs[] = {&a};
    hipError_t e = hipLaunchCooperativeKernel((const void*)fwd_mega, dim3(grid), dim3(NWAVES * 64), kargs, LDS_BYTES, stream);
    if (e != hipSuccess) fprintf(stderr, "kernel_launch: cooperative launch failed: %s (grid %d)\n", hipGetErrorString(e), grid);
#else
    for (int p = 0; p < NPH; ++p) {
        a.ph_lo = p; a.ph_hi = p + 1;
        hipLaunchKernelGGL(fwd_mega, dim3(grid), dim3(NWAVES * 64), LDS_BYTES, stream, a);
        const hipError_t le = hipPeekAtLastError();
        if (le != hipSuccess) { fprintf(stderr, "kernel_launch: launch %d failed: %s\n", p, hipGetErrorName(le)); break; }
    }
#endif
}
```
